# Optimizing an MI355X kernel written in HIP

```python
import jax
import jax.numpy as jnp
from jax import lax
import numpy as np

D_MODEL = 1024
BATCH = 16
SEQ = 2048
DEPTH = 2

D_FF = 2816
NORM_EPS = 1e-6
N_BRANCH = 3

GLA_HEADS = 4
GLA_DK = 64
GLA_DV = 128
GLA_QK = GLA_HEADS * GLA_DK
GLA_V = GLA_HEADS * GLA_DV
GLA_RANK = 16
GLA_TAU = 16.0
GLA_CHUNK = 64

FNET_GROUPS = 4
FNET_GC = 128
FNET_W = FNET_GROUPS * FNET_GC

RWKV_HEADS = 8
RWKV_N = 64
RWKV_W = RWKV_HEADS * RWKV_N
RWKV_DECAY_RANK = 32
RWKV_A_RANK = 32
RWKV_GATE_RANK = 96
RWKV_LN_EPS = 64e-5

RWKV_SPLITS = (RWKV_W, RWKV_W, RWKV_W, RWKV_DECAY_RANK, RWKV_DECAY_RANK, RWKV_A_RANK, RWKV_A_RANK, RWKV_GATE_RANK)
RWKV_COLS = 3 * RWKV_W + 2 * RWKV_DECAY_RANK + 2 * RWKV_A_RANK + RWKV_GATE_RANK
IN_SPLITS = (GLA_QK, GLA_QK, GLA_V, GLA_V, GLA_RANK, GLA_RANK, FNET_W, RWKV_COLS, N_BRANCH * D_MODEL)
IN_COLS = 2 * GLA_QK + 2 * GLA_V + 2 * GLA_RANK + FNET_W + RWKV_COLS + N_BRANCH * D_MODEL

kernel_name = 'hybrid_gla_fnet_rwkv7_macaron_encoder'


def split_cols(t, sizes):
    return jnp.split(t, [int(i) for i in np.cumsum(sizes)[:-1]], axis=-1)


def flip_seq(t):
    return jnp.flip(t, axis=1)


def rms_norm(x, g):
    xf = x.astype(jnp.float32)
    y = xf * lax.rsqrt(jnp.mean(xf * xf, axis=-1, keepdims=True) + NORM_EPS)
    return (y * g.astype(jnp.float32)).astype(x.dtype)


def swiglu(h, w_gate, w_up, w_down):
    return (jax.nn.silu(h @ w_gate) * (h @ w_up)) @ w_down


def gla_chunked(q, k, v, log_a, strict):
    B, S, H, dk = q.shape
    dv = v.shape[-1]
    L = GLA_CHUNK
    nc = S // L

    def chunk(t):
        return t.reshape(B, nc, L, H, t.shape[-1])

    q, k, v, log_a = chunk(q), chunk(k), chunk(v), chunk(log_a)
    b = jnp.cumsum(log_a, axis=2)
    b_last = b[:, :, -1:]
    q_dec = q * jnp.exp(b)
    k_dec = k * jnp.exp(-b)
    k_tail = k * jnp.exp(b_last - b)
    scores = jnp.einsum('bclhk,bcmhk->bchlm', q_dec, k_dec)
    idx = jnp.arange(L)
    mask = (idx[:, None] > idx[None, :]) if strict else (idx[:, None] >= idx[None, :])
    scores = jnp.where(mask, scores, 0.0)
    o_intra = jnp.einsum('bchlm,bcmhv->bclhv', scores, v)
    u = jnp.einsum('bclhk,bclhv->bchkv', k_tail, v)
    chunk_decay = jnp.exp(b_last[:, :, 0])

    def step(state, inp):
        u_c, d_c = inp
        return state * d_c[..., None] + u_c, state

    init = jnp.zeros((B, H, dk, dv), jnp.float32)
    _, prev = lax.scan(step, init, (jnp.moveaxis(u, 1, 0), jnp.moveaxis(chunk_decay, 1, 0)))
    prev = jnp.moveaxis(prev, 0, 1)
    o_inter = jnp.einsum('bclhk,bchkv->bclhv', q_dec, prev)
    return (o_intra + o_inter).reshape(B, S, H, dv)


def gla_branch(q, k, v, r, dn_f, dn_b, up_f, bias_f, up_b, bias_b, norm_g):
    B, S, _ = q.shape
    f32 = jnp.float32

    def heads(t, d):
        return t.astype(f32).reshape(B, S, GLA_HEADS, d)

    q = heads(q, GLA_DK) * (GLA_DK ** -0.5)
    k = heads(k, GLA_DK)
    v = heads(v, GLA_DV)

    def log_decay(dn, up, bias):
        z = dn.astype(f32) @ up.astype(f32) + bias.astype(f32)
        return heads(jax.nn.log_sigmoid(z) / GLA_TAU, GLA_DK)

    la_f = log_decay(dn_f, up_f, bias_f)
    la_b = log_decay(dn_b, up_b, bias_b)
    o_f = gla_chunked(q, k, v, la_f, strict=False)
    o_b = flip_seq(gla_chunked(flip_seq(q), flip_seq(k), flip_seq(v), flip_seq(la_b), strict=True))
    o = o_f + o_b
    o = o * lax.rsqrt(jnp.mean(o * o, axis=-1, keepdims=True) + NORM_EPS)
    o = o.reshape(B, S, GLA_V) * norm_g.astype(f32)
    return o * jax.nn.silu(r.astype(f32))


def fnet_branch(u):
    B, S, _ = u.shape
    z = u.astype(jnp.float32).reshape(B, S, FNET_GROUPS, FNET_GC)
    y = jnp.fft.fft2(z, axes=(1, 3), norm='ortho').real
    return y.astype(jnp.float32).reshape(B, S, FNET_W)


def centred_shift(u, mu):
    prev = jnp.pad(u[:, :-1], ((0, 0), (1, 0), (0, 0)))
    nxt = jnp.pad(u[:, 1:], ((0, 0), (0, 1), (0, 0)))
    return u + mu * (0.5 * (prev + nxt) - u)


def rwkv_scan(r, w, k, v, kk, a, strict):
    B, S, H, N = r.shape

    def step(state, inp):
        r_t, w_t, k_t, v_t, kk_t, a_t = inp
        sa = jnp.einsum('bhvk,bhk->bhv', state, -kk_t)
        new = (state * w_t[:, :, None, :]
               + sa[..., None] * (kk_t * a_t)[:, :, None, :]
               + v_t[..., None] * k_t[:, :, None, :])
        read = state if strict else new
        return new, jnp.einsum('bhvk,bhk->bhv', read, r_t)

    xs = tuple(jnp.moveaxis(t, 1, 0) for t in (r, w, k, v, kk, a))
    _, y = lax.scan(step, jnp.zeros((B, H, N, N), jnp.float32), xs)
    return jnp.moveaxis(y, 0, 1)


def rwkv7_branch(u, mu, w0_f, w2_f, w0_b, w2_b, a0_f, a2_f, a0_b, a2_b, g2, k_k, k_a, r_k, ln_g, ln_b):
    B, S, _ = u.shape
    f32 = jnp.float32
    u = centred_shift(u.astype(f32), mu.astype(f32))
    r, k, v, wd_f, wd_b, ad_f, ad_b, gd = split_cols(u, RWKV_SPLITS)

    def heads(t):
        return t.reshape(B, S, RWKV_HEADS, RWKV_N)

    def decay(wd, w0, w2):
        w = -jax.nn.softplus(-(w0.astype(f32) + jnp.tanh(wd) @ w2.astype(f32))) - 0.5
        return heads(jnp.exp(-jnp.exp(w)))

    def icl_rate(ad, a0, a2):
        return heads(jax.nn.sigmoid(a0.astype(f32) + ad @ a2.astype(f32)))

    w_f, w_b = decay(wd_f, w0_f, w2_f), decay(wd_b, w0_b, w2_b)
    a_f, a_b = icl_rate(ad_f, a0_f, a2_f), icl_rate(ad_b, a0_b, a2_b)
    g = jax.nn.sigmoid(gd) @ g2.astype(f32)
    r, k, v = heads(r), heads(k), heads(v)
    k_k = k_k.astype(f32).reshape(RWKV_HEADS, RWKV_N)
    k_a = k_a.astype(f32).reshape(RWKV_HEADS, RWKV_N)
    r_k = r_k.astype(f32).reshape(RWKV_HEADS, RWKV_N)
    kk = k * k_k
    kk = kk * lax.rsqrt(jnp.sum(kk * kk, axis=-1, keepdims=True) + 1e-12)
    k_f = k * (1.0 + (a_f - 1.0) * k_a)
    k_b = k * (1.0 + (a_b - 1.0) * k_a)
    y_f = rwkv_scan(r, w_f, k_f, v, kk, a_f, strict=False)
    y_b = flip_seq(rwkv_scan(flip_seq(r), flip_seq(w_b), flip_seq(k_b), flip_seq(v),
                             flip_seq(kk), flip_seq(a_b), strict=True))
    y = y_f + y_b
    mean = jnp.mean(y, axis=-1, keepdims=True)
    var = jnp.mean((y - mean) ** 2, axis=-1, keepdims=True)
    y = ((y - mean) * lax.rsqrt(var + RWKV_LN_EPS)).reshape(B, S, RWKV_W)
    y = y * ln_g.astype(f32) + ln_b.astype(f32)
    bonus = (jnp.sum(r * k_f * r_k, axis=-1, keepdims=True) * v).reshape(B, S, RWKV_W)
    return (y + bonus) * g


def hybrid_layer(x, ffn1_norm, ffn1_gate, ffn1_up, ffn1_down, mix_norm, w_in,
                 gla_up_f, gla_bias_f, gla_up_b, gla_bias_b, gla_norm,
                 rwkv_mu, rwkv_w0_f, rwkv_w2_f, rwkv_w0_b, rwkv_w2_b,
                 rwkv_a0_f, rwkv_a2_f, rwkv_a0_b, rwkv_a2_b, rwkv_g2,
                 rwkv_k_k, rwkv_k_a, rwkv_r_k, rwkv_ln_g, rwkv_ln_b,
                 proj_gla, proj_fnet, proj_rwkv, w_out,
                 ffn2_norm, ffn2_gate, ffn2_up, ffn2_down):
    B, S, D = x.shape
    x = x + 0.5 * swiglu(rms_norm(x, ffn1_norm), ffn1_gate, ffn1_up, ffn1_down)
    h = rms_norm(x, mix_norm)
    z = h @ w_in
    q, k, v, r, dn_f, dn_b, u_fnet, u_rwkv, gate = split_cols(z, IN_SPLITS)
    y_a = gla_branch(q, k, v, r, dn_f, dn_b, gla_up_f, gla_bias_f, gla_up_b, gla_bias_b, gla_norm).astype(x.dtype)
    y_b = fnet_branch(u_fnet).astype(x.dtype)
    y_c = rwkv7_branch(u_rwkv, rwkv_mu, rwkv_w0_f, rwkv_w2_f, rwkv_w0_b, rwkv_w2_b,
                       rwkv_a0_f, rwkv_a2_f, rwkv_a0_b, rwkv_a2_b, rwkv_g2,
                       rwkv_k_k, rwkv_k_a, rwkv_r_k, rwkv_ln_g, rwkv_ln_b).astype(x.dtype)
    gates = jax.nn.sigmoid(gate).reshape(B, S, N_BRANCH, D)
    merged = (gates[:, :, 0] * (y_a @ proj_gla)
              + gates[:, :, 1] * (y_b @ proj_fnet)
              + gates[:, :, 2] * (y_c @ proj_rwkv))
    x = x + merged @ w_out
    x = x + 0.5 * swiglu(rms_norm(x, ffn2_norm), ffn2_gate, ffn2_up, ffn2_down)
    return x


def setup_inputs(seed: int = 0) -> dict:
    key = jax.random.key(seed)
    ks = iter(jax.random.split(key, 64))

    def nrm(shape, scale=1.0):
        return scale * jax.random.normal(next(ks), shape, jnp.float32)

    def uni(shape, lo, hi):
        return jax.random.uniform(next(ks), shape, jnp.float32, lo, hi)

    L, D, F = DEPTH, D_MODEL, D_FF
    return {
        'x': nrm((BATCH, SEQ, D)),
        'ffn1_norm': 1.0 + nrm((L, D), 0.02),
        'ffn1_gate': nrm((L, D, F), D ** -0.5),
        'ffn1_up': nrm((L, D, F), D ** -0.5),
        'ffn1_down': nrm((L, F, D), F ** -0.5),
        'mix_norm': 1.0 + nrm((L, D), 0.02),
        'w_in': nrm((L, D, IN_COLS), D ** -0.5),
        'gla_up_f': nrm((L, GLA_RANK, GLA_QK), GLA_RANK ** -0.5),
        'gla_bias_f': nrm((L, GLA_QK), 0.1),
        'gla_up_b': nrm((L, GLA_RANK, GLA_QK), GLA_RANK ** -0.5),
        'gla_bias_b': nrm((L, GLA_QK), 0.1),
        'gla_norm': 1.0 + nrm((L, GLA_V), 0.02),
        'rwkv_mu': uni((L, RWKV_COLS), 0.0, 1.0),
        'rwkv_w0_f': -1.0 + nrm((L, RWKV_W), 0.5),
        'rwkv_w2_f': nrm((L, RWKV_DECAY_RANK, RWKV_W), RWKV_DECAY_RANK ** -0.5),
        'rwkv_w0_b': -1.0 + nrm((L, RWKV_W), 0.5),
        'rwkv_w2_b': nrm((L, RWKV_DECAY_RANK, RWKV_W), RWKV_DECAY_RANK ** -0.5),
        'rwkv_a0_f': nrm((L, RWKV_W), 0.1),
        'rwkv_a2_f': nrm((L, RWKV_A_RANK, RWKV_W), RWKV_A_RANK ** -0.5),
        'rwkv_a0_b': nrm((L, RWKV_W), 0.1),
        'rwkv_a2_b': nrm((L, RWKV_A_RANK, RWKV_W), RWKV_A_RANK ** -0.5),
        'rwkv_g2': nrm((L, RWKV_GATE_RANK, RWKV_W), RWKV_GATE_RANK ** -0.5),
        'rwkv_k_k': 0.85 + nrm((L, RWKV_W), 0.02),
        'rwkv_k_a': 1.0 + nrm((L, RWKV_W), 0.02),
        'rwkv_r_k': nrm((L, RWKV_W), 0.1),
        'rwkv_ln_g': 1.0 + nrm((L, RWKV_W), 0.02),
        'rwkv_ln_b': nrm((L, RWKV_W), 0.02),
        'proj_gla': nrm((L, GLA_V, D), GLA_V ** -0.5),
        'proj_fnet': nrm((L, FNET_W, D), FNET_W ** -0.5),
        'proj_rwkv': nrm((L, RWKV_W, D), RWKV_W ** -0.5),
        'w_out': nrm((L, D, D), D ** -0.5),
        'ffn2_norm': 1.0 + nrm((L, D), 0.02),
        'ffn2_gate': nrm((L, D, F), D ** -0.5),
        'ffn2_up': nrm((L, D, F), D ** -0.5),
        'ffn2_down': nrm((L, F, D), F ** -0.5),
        'final_norm': 1.0 + nrm((D,), 0.02),
    }


def reference(x, ffn1_norm, ffn1_gate, ffn1_up, ffn1_down, mix_norm, w_in,
              gla_up_f, gla_bias_f, gla_up_b, gla_bias_b, gla_norm,
              rwkv_mu, rwkv_w0_f, rwkv_w2_f, rwkv_w0_b, rwkv_w2_b,
              rwkv_a0_f, rwkv_a2_f, rwkv_a0_b, rwkv_a2_b, rwkv_g2,
              rwkv_k_k, rwkv_k_a, rwkv_r_k, rwkv_ln_g, rwkv_ln_b,
              proj_gla, proj_fnet, proj_rwkv, w_out,
              ffn2_norm, ffn2_gate, ffn2_up, ffn2_down, final_norm):
    for l in range(DEPTH):
        x = hybrid_layer(x, ffn1_norm[l], ffn1_gate[l], ffn1_up[l], ffn1_down[l], mix_norm[l], w_in[l],
                         gla_up_f[l], gla_bias_f[l], gla_up_b[l], gla_bias_b[l], gla_norm[l],
                         rwkv_mu[l], rwkv_w0_f[l], rwkv_w2_f[l], rwkv_w0_b[l], rwkv_w2_b[l],
                         rwkv_a0_f[l], rwkv_a2_f[l], rwkv_a0_b[l], rwkv_a2_b[l], rwkv_g2[l],
                         rwkv_k_k[l], rwkv_k_a[l], rwkv_r_k[l], rwkv_ln_g[l], rwkv_ln_b[l],
                         proj_gla[l], proj_fnet[l], proj_rwkv[l], w_out[l],
                         ffn2_norm[l], ffn2_gate[l], ffn2_up[l], ffn2_down[l])
    return rms_norm(x, final_norm)
```

```cpp
#include <hip/hip_runtime.h>
#include <hip/hip_cooperative_groups.h>
#include <cstdio>
namespace cg = cooperative_groups;

#ifndef PHSEL
#define PHSEL -1
#endif
#define PHON(k) (PHSEL < 0 || PHSEL == (k))
#ifndef REP_K
#define REP_K -1
#endif
#ifndef REP_N
#define REP_N 1
#endif
#define REPS(k) (((k) == REP_K) ? REP_N : 1)
#ifndef STG_REP
#define STG_REP 1
#endif
#ifndef ONE_LAUNCH
#define ONE_LAUNCH 1
#endif

#define LAS __attribute__((address_space(3)))
typedef unsigned short bf16_t;
typedef short bf16x8 __attribute__((ext_vector_type(8)));
typedef float f32x4 __attribute__((ext_vector_type(4)));
typedef unsigned u32x4 __attribute__((ext_vector_type(4)));
typedef unsigned u32x2 __attribute__((ext_vector_type(2)));

constexpr int T_ = 32768, D_ = 1024, FF_ = 2816, SEQ_ = 2048, NB_ = 16;
constexpr int ZGC = 1568, ZRC = 1760, ZC = 3328, WINC = 6912;
constexpr size_t MiB = 1ull << 20;
constexpr size_t WS_BON = 1 * MiB, WS_W = 2 * MiB, WS_DM = 55 * MiB, WS_H = 71 * MiB, WS_R = 135 * MiB, WS_Y = 407 * MiB, WS_END = 503 * MiB;
constexpr size_t R_ZG = 0, R_ZR = 98 * MiB, R_FT = 208 * MiB, R_G = 0, R_SCR = 192 * MiB;
constexpr size_t Y_STRIDE = 32 * MiB;
constexpr size_t W_GU1 = 0, W_D1 = W_GU1 + 5632 * 1024, W_IN = W_D1 + 1024 * 2816, W_FOLD = W_IN + 3328 * 1024, W_GATE = W_FOLD + 1024 * 1024,
                 W_PROJ = W_GATE + 3072 * 1024, W_OUT = W_PROJ + 3 * 1024 * 512, W_GU2 = W_OUT + 1024 * 1024, W_D2 = W_GU2 + 5632 * 1024, W_TOTAL = W_D2 + 1024 * 2816;
static_assert(W_TOTAL * 2 <= 53 * MiB, "weights");

struct Params { const float* in[36]; float* out; unsigned char* ws; };
__device__ __forceinline__ const float* INP(const Params& p, int i) { asm volatile("" : "+s"(i)); return p.in[i]; }
__device__ __forceinline__ int TID() { int t = threadIdx.x; asm volatile("" : "+v"(t)); return t; }
__device__ __forceinline__ int BID() { int t = blockIdx.x; asm volatile("" : "+s"(t)); return t; }
__device__ __forceinline__ int NBLK() { int t = gridDim.x; asm volatile("" : "+s"(t)); return t; }
__device__ __forceinline__ unsigned char* WSP(const Params& p) { unsigned char* w = p.ws; asm volatile("" : "+s"(w)); return w; }
__device__ __forceinline__ float* OUTP(const Params& p) { float* w = p.out; asm volatile("" : "+s"(w)); return w; }


typedef float f32x2_t __attribute__((ext_vector_type(2)));
typedef __bf16 bf16x2_t __attribute__((ext_vector_type(2)));
__device__ __forceinline__ unsigned cvt_pk_bf16(float lo, float hi) { const f32x2_t v = {lo, hi}; const bf16x2_t b = __builtin_convertvector(v, bf16x2_t); return __builtin_bit_cast(unsigned, b); }
__device__ __forceinline__ float bf_lo(unsigned w) { return __uint_as_float(w << 16); }
__device__ __forceinline__ float bf_hi(unsigned w) { return __uint_as_float(w & 0xffff0000u); }
__device__ __forceinline__ float bf1(bf16_t b) { return __uint_as_float(((unsigned)b) << 16); }
__device__ __forceinline__ float sigmoid_(float x) { return __builtin_amdgcn_rcpf(1.0f + __expf(-x)); }
__device__ __forceinline__ float softplus_(float x) { return fmaxf(x, 0.f) + __logf(1.0f + __expf(-fabsf(x))); }
__device__ __forceinline__ float tanh_(float x) { const float t = __expf(-2.0f * fabsf(x)); const float r = (1.0f - t) * __builtin_amdgcn_rcpf(1.0f + t); return x < 0.f ? -r : r; }
__device__ __forceinline__ float dppf(float x, const int ctrl_sel) {
    const int xi = __float_as_int(x); int r;
    if (ctrl_sel == 0) r = __builtin_amdgcn_update_dpp(0, xi, 0xB1, 0xF, 0xF, true);
    else if (ctrl_sel == 1) r = __builtin_amdgcn_update_dpp(0, xi, 0x4E, 0xF, 0xF, true);
    else r = __builtin_amdgcn_update_dpp(0, xi, 0x141, 0xF, 0xF, true);
    return __int_as_float(r);
}
__device__ __forceinline__ float red8(float x) { x += dppf(x, 0); x += dppf(x, 1); x += dppf(x, 2); return x; }
__device__ __forceinline__ float red16d(float x) {
    x += dppf(x, 0); x += dppf(x, 1); x += dppf(x, 2); x += __int_as_float(__builtin_amdgcn_update_dpp(0, __float_as_int(x), 0x140, 0xF, 0xF, true)); return x; }
__device__ __forceinline__ float red16(float x) { x += __shfl_xor(x, 1); x += __shfl_xor(x, 2); x += __shfl_xor(x, 4); x += __shfl_xor(x, 8); return x; }
__device__ __forceinline__ void unpack8(const uint4 r, float (&f)[8]) {
    f[0] = bf_lo(r.x); f[1] = bf_hi(r.x); f[2] = bf_lo(r.y); f[3] = bf_hi(r.y); f[4] = bf_lo(r.z); f[5] = bf_hi(r.z); f[6] = bf_lo(r.w); f[7] = bf_hi(r.w);
}
__device__ __forceinline__ uint4 pack8(const float (&f)[8]) { uint4 r; r.x = cvt_pk_bf16(f[0], f[1]); r.y = cvt_pk_bf16(f[2], f[3]); r.z = cvt_pk_bf16(f[4], f[5]); r.w = cvt_pk_bf16(f[6], f[7]); return r; }

#define LBAR() do { asm volatile("s_waitcnt lgkmcnt(0)" ::: "memory"); __builtin_amdgcn_s_barrier(); asm volatile("" ::: "memory"); } while (0)

__device__ __forceinline__ void nt_store16(void* p, const uint4 v) { __builtin_nontemporal_store((u32x4){v.x, v.y, v.z, v.w}, (u32x4*)p); }

namespace pg8 {
constexpr int BM = 256, BK = 64, HALF = 128, HTB = HALF * BK * 2, STAGE_BYTES = 8 * HTB, NXCD = 8, WGM = 8;
__host__ __device__ __forceinline__ int lds_byte(int r, int c) { const int st = (r >> 4) * 2 + (c >> 5), rr = r & 15, cc = c & 31, ob = rr * 64 + cc * 2; return st * 1024 + (ob ^ (((ob >> 9) & 1) << 5)); }
__host__ __device__ __forceinline__ void stage_rc(int b, int& R, int& C) { const int st = b / 1024, sb = b % 1024, swz = sb ^ (((sb >> 9) & 1) << 5); R = (st >> 1) * 16 + swz / 64; C = (st & 1) * 32 + (swz % 64) / 2; }
__host__ __device__ __forceinline__ int perm32(int rho) { const int n = rho >> 4, i = rho & 15; return 8 * (i >> 2) + 4 * n + (i & 3); }

struct Unit { int pm, pn, z; };
struct Gemm { const bf16_t* A; const bf16_t* Bt; int M, N, K; size_t a_zs, b_zs; int a_zmask = -1; };

__device__ __forceinline__ void tile_map(int wgid, int nM, int nN, int nwg, int& pm, int& pn) {
    { const int q = nwg / NXCD, r = nwg % NXCD, xcd = wgid % NXCD, off = wgid / NXCD; wgid = (xcd < r ? xcd * (q + 1) : r * (q + 1) + (xcd - r) * q) + off; }
    const int nig = WGM * nN, gid = wgid / nig, fm = gid * WGM, gsz = (nM - fm) < WGM ? (nM - fm) : WGM;
    pm = fm + ((wgid % nig) % gsz); pn = (wgid % nig) / gsz;
}
struct OrderPlain {
    int nM, nN, nwg, G, c;
    __device__ void init(int M, int N, int G_, int c_) { nM = M / BM; nN = N / BM; nwg = nM * nN; G = G_; c = c_; }
    __device__ __forceinline__ bool next(int i, Unit& u) const { const long L = (long)i * G + c; if (L >= nwg) return false; tile_map((int)L, nM, nN, nwg, u.pm, u.pn); u.z = 0; return true; }
};
struct OrderFill {
    int nM, nN, nwg, G, c, nbig, lo, hi;
    __device__ void init(int M, int N, int G_, int c_, int nbig_, int lo_, int hi_) { nM = M / BM; nN = N / BM; nwg = nM * nN; G = G_; c = c_; nbig = nbig_; lo = lo_; hi = hi_; }
    __device__ __forceinline__ bool next(int i, Unit& u) const {
        int L;
        if (c < nbig) { if (i >= lo) return false; L = c * lo + i; } else { if (i >= hi) return false; L = nbig * lo + (c - nbig) * hi + i; }
        if (L >= nwg) return false;
        tile_map(L, nM, nN, nwg, u.pm, u.pn); u.z = 0; return true; }
};
struct OrderMerge {
    int nM, nN, nwg, G, c;
    __device__ void init(int M, int N, int G_, int c_) { nM = M / BM; nN = N / BM; nwg = nM * nN; G = G_; c = c_; }
    __device__ __forceinline__ bool next(int i, Unit& u) const { const long L = (long)(i / 3) * G + c; if (L >= nwg) return false; tile_map((int)L, nM, nN, nwg, u.pm, u.pn); u.z = i % 3; return true; }
};
struct OrderBatch {
    int nM, per, total, G, c;
    __device__ void init(int M, int N, int nb, int G_, int c_) { nM = M / BM; per = nM * (N / BM); total = per * nb; G = G_; c = c_; }
    __device__ __forceinline__ bool next(int i, Unit& u) const { const long L = (long)i * G + c; if (L >= total) return false; u.z = (int)(L / per); const int r = (int)(L % per); u.pm = r % nM; u.pn = r / nM; return true; }
};

template <class Epi, class Sched, bool HALFN = false>
__device__ __forceinline__ void gemm_phase(LAS unsigned char* lds, const Gemm g, const Sched& S, const Epi& E) {
    const int tid = TID(), wid = __builtin_amdgcn_readfirstlane(tid >> 6), lane = tid & 63, wr = wid >> 2, wc = wid & 3, fr = lane & 15, fq = lane >> 4;
    int K_ = g.K; asm volatile("" : "+s"(K_));
    const int K = K_, nt = K / BK;
    unsigned voffA[2], voffB[2];
#pragma unroll
    for (int i = 0; i < 2; ++i) { int R, C; stage_rc(tid * 16 + i * 8192, R, C); const int Rb = Epi::PERM ? ((R & ~31) + perm32(R & 31)) : R;
        voffA[i] = (unsigned)(R * K + C) * 2u; voffB[i] = (unsigned)(Rb * K + C) * 2u; }
    const size_t kstep = (size_t)(BK * 2);
    const size_t hstep = (size_t)HALF * K * 2;
    const size_t tstep = 2 * hstep;
    const size_t tstepB = HALFN ? hstep : tstep;
    const unsigned ldsw = (unsigned)wid * 1024u;
    const int aoff = lds_byte(wr * 64 + fr, fq * 8), boff = lds_byte(wc * 32 + fr, fq * 8);
#define PG8_SA(b, h) (((b) * 2 + (h)) * HTB)
#define PG8_SB(b, h) ((4 + (b) * 2 + (h)) * HTB)
#define PG8_STAGE(bufoff, gbase, voff) do { _Pragma("unroll") for (int _i = 0; _i < 2; ++_i) \
        __builtin_amdgcn_global_load_lds((const unsigned*)((const char*)(gbase) + (voff)[_i]), (LAS unsigned*)(lds + (bufoff) + ldsw + _i * 8192), 16, 0, 0); } while (0)
#define PG8_LDA(dst, b, h) do { _Pragma("unroll") for (int m = 0; m < 4; ++m) _Pragma("unroll") for (int k = 0; k < 2; ++k) dst[m][k] = *(const LAS bf16x8*)(lds + PG8_SA(b, h) + aoff + m * 2048 + k * 1024); } while (0)
#define PG8_LDB(dst, b, h) do { _Pragma("unroll") for (int n = 0; n < 2; ++n) _Pragma("unroll") for (int k = 0; k < 2; ++k) dst[n][k] = *(const LAS bf16x8*)(lds + PG8_SB(b, h) + boff + n * 2048 + k * 1024); } while (0)
#define PG8_MMA(ai, bj, At, Bt) do { __builtin_amdgcn_s_setprio(1); _Pragma("unroll") for (int m = 0; m < 4; ++m) _Pragma("unroll") for (int n = 0; n < 2; ++n) _Pragma("unroll") for (int k = 0; k < 2; ++k) \
        acc[ai][bj][m][n] = __builtin_amdgcn_mfma_f32_16x16x32_bf16(Bt[n][k], At[m][k], acc[ai][bj][m][n], 0, 0, 0); __builtin_amdgcn_s_setprio(0); } while (0)
#define PG8_WAIT_V(n) asm volatile("s_waitcnt vmcnt(" #n ")" ::: "memory")
#define PG8_WAIT_L(n) asm volatile("s_waitcnt lgkmcnt(" #n ")" ::: "memory")
#define PG8_BAR __builtin_amdgcn_s_barrier()
#define PG8_SCHED __builtin_amdgcn_sched_barrier(0)
    Unit cur, nxt; int ui = 0;
    if (!S.next(0, cur)) return;
    f32x4 acc[2][2][4][2];
#pragma unroll
    for (int a = 0; a < 2; ++a)
#pragma unroll
        for (int b = 0; b < 2; ++b)
#pragma unroll
            for (int m = 0; m < 4; ++m)
#pragma unroll
                for (int n = 0; n < 2; ++n) acc[a][b][m][n] = (f32x4){0.f, 0.f, 0.f, 0.f};
    bf16x8 At[4][2], B0[2][2], B1[2][2];
    const char* cA = (const char*)g.A + (size_t)(cur.z & g.a_zmask) * g.a_zs + (size_t)cur.pm * tstep; const char* cB = (const char*)g.Bt + (size_t)cur.z * g.b_zs + (size_t)cur.pn * tstepB;
    if constexpr (HALFN) {
        PG8_STAGE(PG8_SB(0, 0), cB, voffB); PG8_STAGE(PG8_SA(0, 0), cA, voffA); PG8_STAGE(PG8_SA(0, 1), cA + hstep, voffA);
        if (wr == 1) PG8_BAR;
        PG8_WAIT_V(2); PG8_BAR;
        PG8_STAGE(PG8_SB(1, 0), cB + kstep, voffB); PG8_STAGE(PG8_SA(1, 0), cA + kstep, voffA);
        PG8_WAIT_V(4); PG8_BAR;
    } else {
    PG8_STAGE(PG8_SB(0, 0), cB, voffB); PG8_STAGE(PG8_SB(0, 1), cB + hstep, voffB); PG8_STAGE(PG8_SA(0, 0), cA, voffA); PG8_STAGE(PG8_SA(0, 1), cA + hstep, voffA);
    if (wr == 1) PG8_BAR;
    PG8_WAIT_V(2); PG8_BAR;
    PG8_STAGE(PG8_SB(1, 0), cB + kstep, voffB); PG8_STAGE(PG8_SA(1, 0), cA + kstep, voffA); PG8_STAGE(PG8_SB(1, 1), cB + hstep + kstep, voffB);
    PG8_WAIT_V(6); PG8_BAR;
    }
    for (;;) {
        const bool has_next = S.next(ui + 1, nxt);
        const char* nA = has_next ? (const char*)g.A + (size_t)(nxt.z & g.a_zmask) * g.a_zs + (size_t)nxt.pm * tstep : cA; const char* nB = has_next ? (const char*)g.Bt + (size_t)nxt.z * g.b_zs + (size_t)nxt.pn * tstepB : cB;
#pragma unroll 1
        for (int t = 0; t < nt; t += 2) {
            const bool last = (t == nt - 2);
            const char* a1 = cA + (size_t)(t + 1) * kstep;
            const char* a2 = last ? nA : cA + (size_t)(t + 2) * kstep; const char* b2 = last ? nB : cB + (size_t)(t + 2) * kstep;
            const char* a3 = a2 + kstep; const char* b3 = b2 + kstep;
            if constexpr (HALFN) {
            PG8_LDB(B0, 0, 0); PG8_SCHED; PG8_LDA(At, 0, 0); PG8_STAGE(PG8_SA(1, 1), a1 + hstep, voffA);
            PG8_WAIT_V(6); PG8_WAIT_L(0); PG8_BAR; PG8_MMA(0, 0, At, B0); PG8_BAR; PG8_SCHED;
            PG8_LDA(At, 0, 1); PG8_STAGE(PG8_SB(0, 0), b2, voffB); PG8_STAGE(PG8_SA(0, 0), a2, voffA);
            PG8_WAIT_V(6); PG8_WAIT_L(0); PG8_BAR; PG8_MMA(1, 0, At, B0); PG8_BAR; PG8_SCHED;
            PG8_LDB(B0, 1, 0); PG8_SCHED; PG8_LDA(At, 1, 0); PG8_STAGE(PG8_SA(0, 1), a2 + hstep, voffA);
            PG8_WAIT_V(6); PG8_WAIT_L(0); PG8_BAR; PG8_MMA(0, 0, At, B0); PG8_BAR; PG8_SCHED;
            PG8_LDA(At, 1, 1); PG8_STAGE(PG8_SB(1, 0), b3, voffB); PG8_STAGE(PG8_SA(1, 0), a3, voffA);
            PG8_WAIT_V(6); PG8_WAIT_L(0); PG8_BAR; PG8_MMA(1, 0, At, B0); PG8_BAR; PG8_SCHED;
            } else {
            PG8_LDB(B0, 0, 0); PG8_LDB(B1, 0, 1); PG8_SCHED; PG8_LDA(At, 0, 0); PG8_STAGE(PG8_SA(1, 1), a1 + hstep, voffA);
            PG8_WAIT_V(8); PG8_WAIT_L(0); PG8_BAR; PG8_MMA(0, 0, At, B0); PG8_MMA(0, 1, At, B1); PG8_BAR; PG8_SCHED;
            PG8_LDA(At, 0, 1); PG8_STAGE(PG8_SB(0, 0), b2, voffB); PG8_STAGE(PG8_SB(0, 1), b2 + hstep, voffB); PG8_STAGE(PG8_SA(0, 0), a2, voffA);
            PG8_WAIT_V(8); PG8_WAIT_L(0); PG8_BAR; PG8_MMA(1, 0, At, B0); PG8_MMA(1, 1, At, B1); PG8_BAR; PG8_SCHED;
            PG8_LDB(B0, 1, 0); PG8_LDB(B1, 1, 1); PG8_SCHED; PG8_LDA(At, 1, 0); PG8_STAGE(PG8_SA(0, 1), a2 + hstep, voffA);
            PG8_WAIT_V(8); PG8_WAIT_L(0); PG8_BAR; PG8_MMA(0, 0, At, B0); PG8_MMA(0, 1, At, B1); PG8_BAR; PG8_SCHED;
            PG8_LDA(At, 1, 1); PG8_STAGE(PG8_SB(1, 0), b3, voffB); PG8_STAGE(PG8_SB(1, 1), b3 + hstep, voffB); PG8_STAGE(PG8_SA(1, 0), a3, voffA);
            PG8_WAIT_V(8); PG8_WAIT_L(0); PG8_BAR; PG8_MMA(1, 0, At, B0); PG8_MMA(1, 1, At, B1); PG8_BAR; PG8_SCHED;
            }
        }
        if (wr == 0) PG8_BAR;
        E(acc, cur, wr, wc, fr, fq);
        if (!has_next) break;
#pragma unroll
        for (int a = 0; a < 2; ++a)
#pragma unroll
            for (int b = 0; b < (HALFN ? 1 : 2); ++b)
#pragma unroll
                for (int m = 0; m < 4; ++m)
#pragma unroll
                    for (int n = 0; n < 2; ++n) acc[a][b][m][n] = (f32x4){0.f, 0.f, 0.f, 0.f};
        cur = nxt; cA = nA; cB = nB; ++ui;
        if (wr == 1) PG8_BAR;
    }
    PG8_WAIT_V(0);
    PG8_BAR;
#undef PG8_SA
#undef PG8_SB
#undef PG8_STAGE
#undef PG8_LDA
#undef PG8_LDB
#undef PG8_MMA
#undef PG8_WAIT_V
#undef PG8_WAIT_L
#undef PG8_BAR
#undef PG8_SCHED
}

typedef const f32x4 (&AccT)[2][2][4][2];
typedef f32x4 (&AccM)[2][2][4][2];

struct EpiAct {
    static constexpr bool PERM = true;
    bf16_t* O;
    __device__ __forceinline__ void operator()(AccT acc, const Unit& u, int wr, int wc, int fr, int fq) const {
        const int row0 = u.pm * BM + wr * 64 + fr, col0 = u.pn * 128 + wc * 32 + 8 * fq;
#pragma unroll
        for (int ai = 0; ai < 2; ++ai)
#pragma unroll
            for (int m = 0; m < 4; ++m) {
                bf16_t* rowp = O + (size_t)(row0 + ai * HALF + m * 16) * FF_ + col0;
                float o[8];
#pragma unroll
                for (int n = 0; n < 2; ++n)
#pragma unroll
                    for (int j = 0; j < 4; ++j) { const float gt = acc[ai][0][m][n][j], up = acc[ai][1][m][n][j]; o[n * 4 + j] = gt * sigmoid_(gt) * up; }
                nt_store16(rowp, pack8(o));
            }
    }
};
struct EpiRes {
    static constexpr bool PERM = false;
    const float* xin; float* xout; float scale;
    __device__ __forceinline__ void operator()(AccT acc, const Unit& u, int wr, int wc, int fr, int fq) const {
        const int row0 = u.pm * BM + wr * 64 + fr, col0 = u.pn * BM + wc * 32 + 4 * fq;
#pragma unroll
        for (int ai = 0; ai < 2; ++ai)
#pragma unroll
            for (int m = 0; m < 4; ++m) { const size_t off = (size_t)(row0 + ai * HALF + m * 16) * D_ + col0;
#pragma unroll
                for (int bj = 0; bj < 2; ++bj)
#pragma unroll
                    for (int n = 0; n < 2; ++n) { const f32x4 bs = *(const f32x4*)(xin + off + bj * HALF + n * 16); *(f32x4*)(xout + off + bj * HALF + n * 16) = bs + acc[ai][bj][m][n] * scale; }
                asm volatile("" ::: "memory"); }
    }
};
__device__ __forceinline__ uint4 pack_acc8(const f32x4 a, const f32x4 b, float s) { uint4 w; w.x = cvt_pk_bf16(a[0] * s, a[1] * s); w.y = cvt_pk_bf16(a[2] * s, a[3] * s); w.z = cvt_pk_bf16(b[0] * s, b[1] * s); w.w = cvt_pk_bf16(b[2] * s, b[3] * s); return w; }
struct EpiZ {
    static constexpr bool PERM = true;
    bf16_t* ZG; bf16_t* ZR;
    __device__ __forceinline__ void operator()(AccT acc, const Unit& u, int wr, int wc, int fr, int fq) const {
        const int row0 = u.pm * BM + wr * 64 + fr, col0 = u.pn * BM + wc * 32 + 8 * fq;
#pragma unroll
        for (int ai = 0; ai < 2; ++ai)
#pragma unroll
            for (int m = 0; m < 4; ++m) { const size_t row = (size_t)(row0 + ai * HALF + m * 16);
#pragma unroll
                for (int bj = 0; bj < 2; ++bj) { const int c = col0 + bj * HALF;
                    bf16_t* dst = (c < ZGC) ? (ZG + row * ZGC + c) : (ZR + row * ZRC + (c - ZGC));
                    nt_store16(dst, pack_acc8(acc[ai][bj][m][0], acc[ai][bj][m][1], 1.0f)); } }
    }
};
struct EpiFT {
    static constexpr bool PERM = true;
    bf16_t* FT;
    __device__ __forceinline__ void operator()(AccT acc, const Unit& u, int wr, int wc, int fr, int fq) const {
        const int row0 = u.pm * BM + wr * 64 + fr, col0 = u.pn * BM + wc * 32 + 8 * fq;
#pragma unroll
        for (int ai = 0; ai < 2; ++ai)
#pragma unroll
            for (int m = 0; m < 4; ++m) { const int row = row0 + ai * HALF + m * 16;
#pragma unroll
                for (int bj = 0; bj < 2; ++bj) { const int c = col0 + bj * HALF; const int b = c >> 11, s = c & 2047;
                    nt_store16(FT + ((size_t)((b * 2 + (row & 1)) * 512 + (row >> 1)) * SEQ_ + s), pack_acc8(acc[ai][bj][m][0], acc[ai][bj][m][1], 1.0f)); } }
    }
};
struct EpiFnet {
    static constexpr bool PERM = true;
    bf16_t* PQ;
    __device__ __forceinline__ void operator()(AccT acc, const Unit& u, int wr, int wc, int fr, int fq) const {
        const int row0 = u.pm * BM + wr * 64 + fr, col0 = u.pn * BM + wc * 32 + 8 * fq;
#pragma unroll
        for (int ai = 0; ai < 2; ++ai)
#pragma unroll
            for (int m = 0; m < 4; ++m) { const size_t row = (size_t)u.z * 1024 + (row0 + ai * HALF + m * 16);
#pragma unroll
                for (int bj = 0; bj < 2; ++bj) nt_store16(PQ + row * 512 + col0 + bj * HALF, pack_acc8(acc[ai][bj][m][0], acc[ai][bj][m][1], 1.0f / 512.0f)); }
    }
};
struct EpiGate {
    static constexpr bool PERM = true;
    bf16_t* G;
    __device__ __forceinline__ void operator()(AccT acc, const Unit& u, int wr, int wc, int fr, int fq) const {
        const int row0 = u.pm * BM + wr * 64 + fr, col0 = u.pn * BM + wc * 32 + 8 * fq;
#pragma unroll
        for (int ai = 0; ai < 2; ++ai)
#pragma unroll
            for (int m = 0; m < 4; ++m) { const size_t row = (size_t)(row0 + ai * HALF + m * 16);
#pragma unroll
                for (int bj = 0; bj < 2; ++bj) { float o[8];
#pragma unroll
                    for (int n = 0; n < 2; ++n)
#pragma unroll
                        for (int j = 0; j < 4; ++j) o[n * 4 + j] = sigmoid_(acc[ai][bj][m][n][j]);
                    nt_store16(G + row * 3072 + col0 + bj * HALF, pack8(o)); } }
    }
};
struct EpiMerge {
    static constexpr bool PERM = true;
    const bf16_t* G; bf16_t* MB;
    __device__ __forceinline__ void operator()(AccM acc, const Unit& u, int wr, int wc, int fr, int fq) const {
        const int row0 = u.pm * BM + wr * 64 + fr, col0 = u.pn * HALF + wc * 32 + 8 * fq;
        const bf16_t* gb = G + (size_t)row0 * 3072 + u.z * 1024 + col0;
        bf16_t* mb = MB + (size_t)row0 * D_ + col0;
        const int z = u.z;
#pragma unroll
        for (int ai = 0; ai < 2; ++ai)
#pragma unroll
            for (int m = 0; m < 4; ++m) {
                const u32x4 gr_ = __builtin_nontemporal_load((const u32x4*)(gb + (size_t)(ai * HALF + m * 16) * 3072)); const uint4 gr = make_uint4(gr_[0], gr_[1], gr_[2], gr_[3]); float gf[8]; unpack8(gr, gf);
                f32x4 v0, v1;
#pragma unroll
                for (int j = 0; j < 4; ++j) { v0[j] = gf[j] * acc[ai][0][m][0][j]; v1[j] = gf[4 + j] * acc[ai][0][m][1][j]; }
                if (z > 0) { v0 += acc[ai][1][m][0]; v1 += acc[ai][1][m][1]; }
                acc[ai][1][m][0] = v0; acc[ai][1][m][1] = v1;
                if (z == 2) nt_store16(mb + (size_t)(ai * HALF + m * 16) * D_, pack_acc8(v0, v1, 1.0f));
                asm volatile("" ::: "memory");
            }
    }
};
}

__device__ __forceinline__ void tr_cvt(const float* __restrict__ src, const float* __restrict__ src2, int srcsel, int ld, int K, int N, bf16_t* __restrict__ dst, LAS float* tl) {
    const int tid = TID(), nkt = K / 64, nnt = N / 64, ntiles = nkt * nnt;
    const int lr = tid >> 4, lc = (tid & 15) * 4;
    const int wn = tid >> 3, wk = (tid & 7) * 8;
    float4 va[2], vb[2]; va[0] = va[1] = vb[0] = vb[1] = make_float4(0.f, 0.f, 0.f, 0.f);
#define TRC_LOAD(tt, q) do { const int kt_ = (tt) % nkt, nn_ = (tt) / nkt; const int n0_ = nn_ * 64, k0_ = kt_ * 64; const float* sp_; int c0_; \
        if (srcsel == 0) { sp_ = src; c0_ = n0_; } else { const int w_ = n0_ & 255; sp_ = (w_ < 128) ? src : src2; c0_ = (n0_ >> 8) * 128 + (w_ & 127); } \
        va[q] = *(const float4*)(sp_ + (size_t)(k0_ + lr) * ld + c0_ + lc); vb[q] = *(const float4*)(sp_ + (size_t)(k0_ + lr + 32) * ld + c0_ + lc); } while (0)
    const int G2 = 2 * NBLK();
    int t = BID();
    if (t < ntiles) TRC_LOAD(t, 0);
    if (t + NBLK() < ntiles) TRC_LOAD(t + NBLK(), 1);
    for (; t < ntiles; t += G2) {
        const bool has2 = t + NBLK() < ntiles;
        LBAR();
#pragma unroll
        for (int q = 0; q < 2; ++q) if (q == 0 || has2) {
            float4 x0 = va[q], x1 = vb[q];
            LAS float* r0 = tl + q * 4160 + lr * 65 + lc; LAS float* r1 = tl + q * 4160 + (lr + 32) * 65 + lc;
            r0[0] = x0.x; r0[1] = x0.y; r0[2] = x0.z; r0[3] = x0.w; r1[0] = x1.x; r1[1] = x1.y; r1[2] = x1.z; r1[3] = x1.w; }
        if (t + G2 < ntiles) TRC_LOAD(t + G2, 0);
        if (t + G2 + NBLK() < ntiles) TRC_LOAD(t + G2 + NBLK(), 1);
        LBAR();
#pragma unroll
        for (int q = 0; q < 2; ++q) if (q == 0 || has2) {
            const int tt = t + q * NBLK(); const int n0 = (tt / nkt) * 64, k0 = (tt % nkt) * 64;
            float f[8];
#pragma unroll
            for (int j = 0; j < 8; ++j) f[j] = tl[q * 4160 + (wk + j) * 65 + wn];
            *(uint4*)(dst + (size_t)(n0 + wn) * K + k0 + wk) = pack8(f); }
    }
#undef TRC_LOAD
}
__device__ void prep_phase(const Params& p, int l, LAS unsigned char* lds) {
    const int tid = TID(), gtid = BID() * 512 + tid, gsz = NBLK() * 512;
    bf16_t* W = (bf16_t*)(WSP(p) + WS_W);
    LAS float* cosT = (LAS float*)lds; LAS float* sinT = cosT + 128;
    if (tid < 128) { cosT[tid] = cospif((float)tid * (1.0f / 64.0f)); sinT[tid] = sinpif((float)tid * (1.0f / 64.0f)); }
    __syncthreads();
    const float* w_in = INP(p, 6) + (size_t)l * D_ * WINC;
    LAS float* tl = (LAS float*)(lds + 4096);
    tr_cvt(INP(p, 2) + (size_t)l * D_ * FF_, INP(p, 3) + (size_t)l * D_ * FF_, 1, FF_, D_, 5632, W + W_GU1, tl);
    tr_cvt(INP(p, 4) + (size_t)l * FF_ * D_, nullptr, 0, D_, FF_, D_, W + W_D1, tl);
    tr_cvt(w_in, nullptr, 0, WINC, D_, 1536, W + W_IN, tl);
    tr_cvt(w_in + 2080, nullptr, 0, WINC, D_, ZRC - 32, W + W_IN + (size_t)ZGC * D_, tl);
    tr_cvt(w_in + 3840, nullptr, 0, WINC, D_, 3072, W + W_GATE, tl);
    tr_cvt(INP(p, 27) + (size_t)l * 512 * D_, nullptr, 0, D_, 512, D_, W + W_PROJ, tl);
    tr_cvt(INP(p, 28) + (size_t)l * 512 * D_, nullptr, 0, D_, 512, D_, W + W_PROJ + 1024 * 512, tl);
    tr_cvt(INP(p, 29) + (size_t)l * 512 * D_, nullptr, 0, D_, 512, D_, W + W_PROJ + 2 * 1024 * 512, tl);
    tr_cvt(INP(p, 30) + (size_t)l * D_ * D_, nullptr, 0, D_, D_, D_, W + W_OUT, tl);
    tr_cvt(INP(p, 32) + (size_t)l * D_ * FF_, INP(p, 33) + (size_t)l * D_ * FF_, 1, FF_, D_, 5632, W + W_GU2, tl);
    tr_cvt(INP(p, 34) + (size_t)l * FF_ * D_, nullptr, 0, D_, FF_, D_, W + W_D2, tl);
    for (int i = gtid; i < 64 * (D_ / 8); i += gsz) {
        const int n = i & 63, kc = i >> 6; const int srccol = (n < 32) ? (1536 + n) : (2080 + 1728 + (n - 32)); const int drow = (n < 32) ? (1536 + n) : (ZGC + 1728 + (n - 32));
        float v[8];
#pragma unroll
        for (int j = 0; j < 8; ++j) v[j] = w_in[(size_t)(kc * 8 + j) * WINC + srccol];
        *(uint4*)(W + W_IN + (size_t)drow * D_ + kc * 8) = pack8(v);
    }
    {   LAS float* ws_ = (LAS float*)(lds + 2048);
        const int q = tid >> 7, cp = tid & 127;
        for (int pr = BID() * 4; pr < 4096; pr += NBLK() * 4) {
            const int pair = pr + q, k = pair >> 2, g = pair & 3;
            __syncthreads();
            ws_[tid] = w_in[(size_t)k * WINC + 1568 + g * 128 + cp];
            __syncthreads();
            float ca = 0.f, sa = 0.f;
#pragma unroll 8
            for (int c = 0; c < 128; ++c) { const float w = ws_[q * 128 + c]; const int j = (c * cp) & 127; ca += w * cosT[j]; sa += w * sinT[j]; }
            const size_t n0 = (size_t)(g * 128 + cp) * 2;
            W[W_FOLD + n0 * 1024 + k] = (bf16_t)(cvt_pk_bf16(ca, ca) & 0xffffu); W[W_FOLD + (n0 + 1) * 1024 + k] = (bf16_t)(cvt_pk_bf16(sa, sa) & 0xffffu);
        }
    }
    if (l == 0) {
        unsigned* DM = (unsigned*)(WSP(p) + WS_DM);
        for (int i = gtid; i < 2 * 1024 * 1024; i += gsz) {
            const int part = i >> 20, sp = (i >> 10) & 1023, s0 = (i & 1023) * 2;
            const int j0 = (sp * s0) & 2047, j1 = (sp * (s0 + 1)) & 2047;
            float v0, v1;
            if (part) { v0 = sinpif((float)j0 * (1.0f / 1024.0f)); v1 = sinpif((float)j1 * (1.0f / 1024.0f)); }
            else { v0 = cospif((float)j0 * (1.0f / 1024.0f)); v1 = cospif((float)j1 * (1.0f / 1024.0f)); }
            DM[i] = cvt_pk_bf16(v0, v1);
        }
    }
}

__device__ void fnet_nyquist_phase(const Params& p) {
    const int lane = TID() & 63, gw = BID() * 8 + (TID() >> 6), nw = NBLK() * 8;
    const bf16_t* FT = (const bf16_t*)(WSP(p) + WS_R + R_FT); bf16_t* YB = (bf16_t*)(WSP(p) + WS_Y + Y_STRIDE);
    for (int pr = gw; pr < NB_ * 512; pr += nw) {
        const int b = pr >> 9, n = pr & 511;
        const bf16_t* a = FT + ((size_t)(b * 2) * 512 + n) * SEQ_;
        float acc = 0.f;
#pragma unroll
        for (int i = 0; i < 4; ++i) { float f[8]; unpack8(*(const uint4*)(a + (lane + 64 * i) * 8), f); acc += (f[0] - f[1]) + (f[2] - f[3]) + (f[4] - f[5]) + (f[6] - f[7]); }
#pragma unroll
        for (int o = 32; o >= 1; o >>= 1) acc += __shfl_xor(acc, o);
        if (lane == 0) { const float y = acc * (1.0f / 512.0f); YB[((size_t)b * SEQ_ + 1024) * 512 + n] = (bf16_t)(cvt_pk_bf16(y, y) & 0xffffu); }
    }
}
__device__ void fnet_combine_phase(const Params& p) {
    const int gtid = BID() * 512 + TID(), gsz = NBLK() * 512;
    const bf16_t* PQ = (const bf16_t*)(WSP(p) + WS_H + 32 * MiB); bf16_t* YB = (bf16_t*)(WSP(p) + WS_Y + Y_STRIDE);
    for (int idx = gtid; idx < NB_ * 1024 * 64; idx += gsz) {
        const int n8 = (idx & 63) * 8, sp = (idx >> 6) & 1023, b = idx >> 16;
        float pf[8], qf[8], d[8], sm[8];
        unpack8(*(const uint4*)(PQ + ((size_t)(b * 2) * 1024 + sp) * 512 + n8), pf); unpack8(*(const uint4*)(PQ + ((size_t)(b * 2 + 1) * 1024 + sp) * 512 + n8), qf);
#pragma unroll
        for (int j = 0; j < 8; ++j) { d[j] = pf[j] - qf[j]; sm[j] = pf[j] + qf[j]; }
        *(uint4*)(YB + ((size_t)b * SEQ_ + sp) * 512 + n8) = pack8(d);
        if (sp > 0) *(uint4*)(YB + ((size_t)b * SEQ_ + (SEQ_ - sp)) * 512 + n8) = pack8(sm);
    }
}

__device__ void rmsnorm_phase(const float* __restrict__ x, const float* __restrict__ g, bf16_t* h, float* outf) {
    const int lane = TID() & 63, gw = BID() * 8 + (TID() >> 6), nw = NBLK() * 8;
    float4 gv[4];
#pragma unroll
    for (int i = 0; i < 4; ++i) gv[i] = ((const float4*)g)[lane + 64 * i];
    for (int row = gw; row < T_; row += nw) {
        const float4* xr = (const float4*)(x + (size_t)row * D_);
        float4 v[4]; float ss = 0.f;
#pragma unroll
        for (int i = 0; i < 4; ++i) { v[i] = xr[lane + 64 * i]; ss += v[i].x * v[i].x + v[i].y * v[i].y + v[i].z * v[i].z + v[i].w * v[i].w; }
#pragma unroll
        for (int o = 32; o >= 1; o >>= 1) ss += __shfl_xor(ss, o);
        const float rs = rsqrtf(ss * (1.0f / 1024.0f) + 1e-6f);
#pragma unroll
        for (int i = 0; i < 4; ++i) {
            const float a = v[i].x * rs * gv[i].x, b = v[i].y * rs * gv[i].y, c = v[i].z * rs * gv[i].z, d = v[i].w * rs * gv[i].w;
            if (outf) ((float4*)(outf + (size_t)row * D_))[lane + 64 * i] = make_float4(a, b, c, d);
            else { u32x2 w; w.x = cvt_pk_bf16(a, b); w.y = cvt_pk_bf16(c, d); *(u32x2*)(h + (size_t)row * D_ + (lane + 64 * i) * 4) = w; }
        }
    }
}


struct GlaOps { f32x4 a0, a1, k0, k1, q0, q1; float vv; };
__device__ __forceinline__ GlaOps gla_load(const LAS float* q_s, int s, int v, int ko) {
    GlaOps o; const LAS float* b = q_s + s * 64 + ko * 8;
    o.q0 = *(const LAS f32x4*)(b); o.q1 = *(const LAS f32x4*)(b + 4);
    o.k0 = *(const LAS f32x4*)(b + 4096); o.k1 = *(const LAS f32x4*)(b + 4100);
    o.a0 = *(const LAS f32x4*)(b + 8192); o.a1 = *(const LAS f32x4*)(b + 8196);
    o.vv = q_s[12288 + s * 64 + v]; return o;
}
template <int DIR> __device__ __forceinline__ void gla_step(float (&S)[8], const GlaOps& p, LAS float* o_s, int s, int v, int ko) {
    float o = 0.f;
    if (DIR) {
#pragma unroll
        for (int j = 0; j < 4; ++j) { S[j] *= p.a0[j]; S[4 + j] *= p.a1[j]; o += p.q0[j] * S[j] + p.q1[j] * S[4 + j]; S[j] += p.k0[j] * p.vv; S[4 + j] += p.k1[j] * p.vv; }
    } else {
#pragma unroll
        for (int j = 0; j < 4; ++j) { S[j] = S[j] * p.a0[j] + p.k0[j] * p.vv; S[4 + j] = S[4 + j] * p.a1[j] + p.k1[j] * p.vv; o += p.q0[j] * S[j] + p.q1[j] * S[4 + j]; }
    }
    o = red8(o);
    if (ko == 0) o_s[s * 64 + v] = o;
}
template <int DIR> __device__ __forceinline__ void gla_steps(float (&S)[8], LAS float* q_s, int v, int ko) {
    LAS float* o_s = q_s + 16384;
    GlaOps a = gla_load(q_s, DIR ? 63 : 0, v, ko);
#pragma unroll 1
    for (int si = 0; si < 64; si += 2) {
        const int s0 = DIR ? 63 - si : si, s1 = DIR ? 62 - si : si + 1, s2 = DIR ? (si < 62 ? 61 - si : 0) : (si < 62 ? si + 2 : 63);
        const GlaOps b = gla_load(q_s, s1, v, ko);
        gla_step<DIR>(S, a, o_s, s0, v, ko);
        a = gla_load(q_s, s2, v, ko);
        gla_step<DIR>(S, b, o_s, s1, v, ko);
    }
}

__device__ void gla_scan_phase(const Params& p, int l, LAS unsigned char* lds) {
    const int tid = TID();
    const bf16_t* ZG = (const bf16_t*)(WSP(p) + WS_R + R_ZG);
    LAS float* q_s = (LAS float*)lds; LAS float* k_s = q_s + 4096; LAS float* a_s = k_s + 4096; LAS float* v_s = a_s + 4096; LAS float* o_s = v_s + 4096;
    LAS float* up_s = o_s + 4096; LAS float* dn_s = up_s + 1024; LAS float* bias_s = dn_s + 1024;
    for (int w = BID(); w < 256; w += NBLK()) {
        const int vh = w & 1, dir = (w >> 1) & 1, h = (w >> 2) & 3, b = w >> 4;
        const float* up = (dir ? INP(p, 9) : INP(p, 7)) + (size_t)l * 16 * 256; const float* bias = (dir ? INP(p, 10) : INP(p, 8)) + (size_t)l * 256;
        bf16_t* O = dir ? (bf16_t*)(WSP(p) + WS_H) : (bf16_t*)(WSP(p) + WS_Y);
        __syncthreads();
        for (int i = tid; i < 1024; i += 512) up_s[i] = up[(i >> 6) * 256 + h * 64 + (i & 63)];
        if (tid < 64) bias_s[tid] = bias[h * 64 + tid];
        float S[8];
#pragma unroll
        for (int j = 0; j < 8; ++j) S[j] = 0.f;
        const int v = tid >> 3, ko = tid & 7;
        const int ltok = tid >> 3, lc8 = (tid & 7) * 8;
        const int dtok = (tid & 127) >> 1, dc8 = (tid & 1) * 8;
        const int dncol = dir ? 1552 : 1536;
        uint4 rq, rk, rv, rd; rd = make_uint4(0, 0, 0, 0);
        {   const int c = dir ? 31 : 0; const size_t tb = (size_t)b * SEQ_ + c * 64;
            const bf16_t* zr = ZG + (tb + ltok) * ZGC;
            rq = *(const uint4*)(zr + h * 64 + lc8); rk = *(const uint4*)(zr + 256 + h * 64 + lc8); rv = *(const uint4*)(zr + 512 + h * 128 + vh * 64 + lc8);
            if (tid < 128) rd = *(const uint4*)(ZG + (tb + dtok) * ZGC + dncol + dc8); }
        for (int ci = 0; ci < 32; ++ci) {
            const int c = dir ? 31 - ci : ci; const size_t t0 = (size_t)b * SEQ_ + c * 64;
            __syncthreads();
            {   float f[8];
                unpack8(rq, f);
#pragma unroll
                for (int j = 0; j < 8; ++j) q_s[ltok * 64 + lc8 + j] = f[j] * 0.125f;
                unpack8(rk, f);
#pragma unroll
                for (int j = 0; j < 8; ++j) k_s[ltok * 64 + lc8 + j] = f[j];
                unpack8(rv, f);
#pragma unroll
                for (int j = 0; j < 8; ++j) v_s[ltok * 64 + lc8 + j] = f[j];
                if (tid < 128) { unpack8(rd, f);
#pragma unroll
                    for (int j = 0; j < 8; ++j) dn_s[dtok * 16 + dc8 + j] = f[j]; } }
            __syncthreads();
            {   float z[8];
#pragma unroll
                for (int j = 0; j < 8; ++j) z[j] = bias_s[lc8 + j];
#pragma unroll
                for (int i = 0; i < 16; ++i) { const float d = dn_s[ltok * 16 + i];
#pragma unroll
                    for (int j = 0; j < 8; ++j) z[j] += d * up_s[i * 64 + lc8 + j]; }
#pragma unroll
                for (int j = 0; j < 8; ++j) a_s[ltok * 64 + lc8 + j] = __expf(-softplus_(-z[j]) * (1.0f / 16.0f)); }
            if (ci + 1 < 32) {
                const int cn = dir ? 30 - ci : ci + 1; const size_t tb = (size_t)b * SEQ_ + cn * 64;
                const bf16_t* zr = ZG + (tb + ltok) * ZGC;
                rq = *(const uint4*)(zr + h * 64 + lc8); rk = *(const uint4*)(zr + 256 + h * 64 + lc8); rv = *(const uint4*)(zr + 512 + h * 128 + vh * 64 + lc8);
                if (tid < 128) rd = *(const uint4*)(ZG + (tb + dtok) * ZGC + dncol + dc8); }
            __syncthreads();
            if (dir) gla_steps<1>(S, q_s, v, ko); else gla_steps<0>(S, q_s, v, ko);
            __syncthreads();
            {   float f[8];
#pragma unroll
                for (int j = 0; j < 8; ++j) f[j] = o_s[ltok * 64 + lc8 + j];
                *(uint4*)(O + (t0 + ltok) * 512 + h * 128 + vh * 64 + lc8) = pack8(f); }
        }
    }
}

template <int KS> __device__ __forceinline__ f32x4 mm_nt(const LAS bf16_t* X, int ldx, int xr, const LAS bf16_t* Y, int ldy, int yr, int r16, int quad, f32x4 acc) {
#pragma unroll
    for (int ks = 0; ks < KS; ++ks) {
        const bf16x8 a = *(const LAS bf16x8*)(X + (xr + r16) * ldx + ks * 32 + quad * 8), b = *(const LAS bf16x8*)(Y + (yr + r16) * ldy + ks * 32 + quad * 8);
        acc = __builtin_amdgcn_mfma_f32_16x16x32_bf16(a, b, acc, 0, 0, 0); }
    return acc;
}
typedef short s4v __attribute__((ext_vector_type(4)));
__device__ __forceinline__ bf16x8 trfrag(const LAS bf16_t* M, int ld, int krow0, int col0, int lane) {
    const int quad = lane >> 4, q = (lane & 15) >> 2, pp = lane & 3;
    const LAS bf16_t* a = M + (krow0 + quad * 8 + q) * ld + col0 + 4 * pp;
    const s4v lo = __builtin_amdgcn_ds_read_tr16_b64_v4i16((LAS s4v*)a);
    const s4v hi = __builtin_amdgcn_ds_read_tr16_b64_v4i16((LAS s4v*)(a + 4 * ld));
    bf16x8 r; r[0] = lo[0]; r[1] = lo[1]; r[2] = lo[2]; r[3] = lo[3]; r[4] = hi[0]; r[5] = hi[1]; r[6] = hi[2]; r[7] = hi[3];
    return r;
}
__device__ __forceinline__ void st_bf(LAS bf16_t* p, float x) { *p = (bf16_t)(cvt_pk_bf16(x, x) & 0xffffu); }
__device__ __forceinline__ void st_bf4(LAS bf16_t* p, const f32x4 v) { u32x2 w; w.x = cvt_pk_bf16(v[0], v[1]); w.y = cvt_pk_bf16(v[2], v[3]); *(LAS u32x2*)p = w; }
__device__ __forceinline__ float ld_bf(const LAS bf16_t* p) { return bf1(*p); }

__device__ void gla_chunk_phase(const Params& p, int l, LAS unsigned char* lds) {
    const int tid = TID(), lane = tid & 63, wid = tid >> 6;
    const bf16_t* ZG = (const bf16_t*)(WSP(p) + WS_R + R_ZG);
    LAS float* b_s = (LAS float*)lds;
    LAS bf16_t* qd = (LAS bf16_t*)(lds + 16384); LAS bf16_t* kd = qd + 4608; LAS bf16_t* ktT = kd + 4608; LAS bf16_t* vT = ktT + 4608; LAS bf16_t* Pm = vT + 4608; LAS bf16_t* stT = Pm + 4608;
    LAS float* o_s = (LAS float*)(lds + 71680);
    LAS bf16_t* upT = (LAS bf16_t*)(lds + 88064); LAS bf16_t* dnA = (LAS bf16_t*)(lds + 93184);
    LAS float* bias_s = (LAS float*)(lds + 98304); LAS float* dk_s = bias_s + 64; LAS float* tot_s = dk_s + 64;
    LAS bf16_t* laT_hi = (LAS bf16_t*)(lds + 99328); LAS bf16_t* laT_lo = laT_hi + 4608; LAS bf16_t* Lm = laT_lo + 4608;
    for (int w = BID(); w < 256; w += NBLK()) {
        const int vh = w & 1, dir = (w >> 1) & 1, h = (w >> 2) & 3, b = w >> 4;
        const float* up = (dir ? INP(p, 9) : INP(p, 7)) + (size_t)l * 16 * 256; const float* bias = (dir ? INP(p, 10) : INP(p, 8)) + (size_t)l * 256;
        bf16_t* O = dir ? (bf16_t*)(WSP(p) + WS_H) : (bf16_t*)(WSP(p) + WS_Y);
        __syncthreads();
        for (int i = tid; i < 64 * 40; i += 512) { const int col = i / 40, k = i - col * 40; st_bf(upT + i, (k < 16) ? up[k * 256 + h * 64 + col] : 0.f); st_bf(dnA + i, 0.f); }
        for (int i = tid; i < 64 * 72; i += 512) { const int t = i / 72, ii = i - t * 72; st_bf(Lm + i, (ii <= t && ii < 64) ? 1.0f : 0.f); }
        if (tid < 64) bias_s[tid] = bias[h * 64 + tid];
        for (int i = tid; i < 2304; i += 512) ((LAS unsigned*)stT)[i] = 0u;
        f32x4 sacc[2] = {{0.f, 0.f, 0.f, 0.f}, {0.f, 0.f, 0.f, 0.f}};
        const int ltok = tid >> 3, lc8 = (tid & 7) * 8;
        const int dtok = (tid & 127) >> 1, dc8 = (tid & 1) * 8;
        const int ltokm = dir ? 63 - ltok : ltok, dtokm = dir ? 63 - dtok : dtok;
        const int dncol = dir ? 1552 : 1536;
        const int tr = wid & 3, tcb = (wid >> 2) * 2, r16 = lane & 15, quad = lane >> 4;
        uint4 rq, rk, rv, rd; rd = make_uint4(0, 0, 0, 0);
        {   const int c = dir ? 31 : 0; const size_t tb = (size_t)b * SEQ_ + c * 64;
            const bf16_t* zr = ZG + (tb + ltokm) * ZGC;
            rq = *(const uint4*)(zr + h * 64 + lc8); rk = *(const uint4*)(zr + 256 + h * 64 + lc8); rv = *(const uint4*)(zr + 512 + h * 128 + vh * 64 + lc8);
            if (tid < 128) rd = *(const uint4*)(ZG + (tb + dtokm) * ZGC + dncol + dc8); }
#pragma unroll 1
        for (int ci = 0; ci < 32; ++ci) {
            const int c = dir ? 31 - ci : ci; const size_t t0 = (size_t)b * SEQ_ + c * 64;
            LBAR();
            if (tid < 128) *(LAS u32x4*)(dnA + dtok * 40 + dc8) = (u32x4){rd.x, rd.y, rd.z, rd.w};
            float fq[8], fk[8], fv[8];
            unpack8(rq, fq); unpack8(rk, fk); unpack8(rv, fv);
            if (ci + 1 < 32) {
                const int cn = dir ? 30 - ci : ci + 1; const size_t tb = (size_t)b * SEQ_ + cn * 64;
                const bf16_t* zr = ZG + (tb + ltokm) * ZGC;
                rq = *(const uint4*)(zr + h * 64 + lc8); rk = *(const uint4*)(zr + 256 + h * 64 + lc8); rv = *(const uint4*)(zr + 512 + h * 128 + vh * 64 + lc8);
                if (tid < 128) rd = *(const uint4*)(ZG + (tb + dtokm) * ZGC + dncol + dc8); }
            LBAR();
#pragma unroll
            for (int i = 0; i < 2; ++i) { const int id = wid + 8 * i, rt = id >> 2, ct = id & 3; const f32x4 z4 = {0.f, 0.f, 0.f, 0.f};
                const f32x4 z = mm_nt<1>(dnA, 40, rt * 16, upT, 40, ct * 16, r16, quad, z4);
                const int col = ct * 16 + r16; const float bz = bias_s[col];
                f32x4 la, lo;
#pragma unroll
                for (int j = 0; j < 4; ++j) la[j] = -softplus_(-(z[j] + bz)) * (1.0f / 16.0f);
                const unsigned h01 = cvt_pk_bf16(la[0], la[1]), h23 = cvt_pk_bf16(la[2], la[3]);
                lo[0] = la[0] - bf_lo(h01); lo[1] = la[1] - bf_hi(h01); lo[2] = la[2] - bf_lo(h23); lo[3] = la[3] - bf_hi(h23);
                u32x2 hw; hw.x = h01; hw.y = h23; *(LAS u32x2*)(laT_hi + col * 72 + rt * 16 + quad * 4) = hw;
                st_bf4(laT_lo + col * 72 + rt * 16 + quad * 4, lo); }
            LBAR();
#pragma unroll
            for (int i = 0; i < 2; ++i) { const int id = wid + 8 * i, rt = id >> 2, ct = id & 3; const f32x4 z4 = {0.f, 0.f, 0.f, 0.f};
                f32x4 acc = mm_nt<2>(Lm, 72, rt * 16, laT_hi, 72, ct * 16, r16, quad, z4);
                acc = mm_nt<2>(Lm, 72, rt * 16, laT_lo, 72, ct * 16, r16, quad, acc);
                const int col = ct * 16 + r16;
#pragma unroll
                for (int j = 0; j < 4; ++j) b_s[(rt * 16 + quad * 4 + j) * 64 + col] = acc[j];
                if (rt == 3 && quad == 3) { tot_s[col] = acc[3]; dk_s[col] = __expf(acc[3]); } }
            LBAR();
            {   const f32x4 b0 = *(const LAS f32x4*)(b_s + ltok * 64 + lc8), b1 = *(const LAS f32x4*)(b_s + ltok * 64 + lc8 + 4);
                const f32x4 d0 = *(const LAS f32x4*)(dk_s + lc8), d1 = *(const LAS f32x4*)(dk_s + lc8 + 4);
                float qv[8], kv[8], ktv[8];
#pragma unroll
                for (int j = 0; j < 8; ++j) {
                    const float bb = (j < 4) ? b0[j & 3] : b1[j & 3], dkj = (j < 4) ? d0[j & 3] : d1[j & 3];
                    const float e = __expf(bb), einv = __builtin_amdgcn_rcpf(e);
                    qv[j] = fq[j] * 0.125f * e; kv[j] = fk[j] * einv;
                    ktv[j] = kv[j] * dkj;
                }
                const uint4 q4 = pack8(qv), k4 = pack8(kv), t4 = pack8(ktv), v4 = pack8(fv);
                *(LAS u32x4*)(qd + ltok * 72 + lc8) = (u32x4){q4.x, q4.y, q4.z, q4.w}; *(LAS u32x4*)(kd + ltok * 72 + lc8) = (u32x4){k4.x, k4.y, k4.z, k4.w};
                *(LAS u32x4*)(ktT + ltok * 72 + lc8) = (u32x4){t4.x, t4.y, t4.z, t4.w}; *(LAS u32x4*)(vT + ltok * 72 + lc8) = (u32x4){v4.x, v4.y, v4.z, v4.w}; }
            LBAR();
            f32x4 oacc[2] = {{0.f, 0.f, 0.f, 0.f}, {0.f, 0.f, 0.f, 0.f}};
            {
                f32x4 sc[2] = {{0.f, 0.f, 0.f, 0.f}, {0.f, 0.f, 0.f, 0.f}};
                const f32x4 dkv = *(const LAS f32x4*)(dk_s + tr * 16 + quad * 4);
                sacc[0] *= dkv; sacc[1] *= dkv;
                const int arow = (tr * 16 + r16) * 72 + quad * 8;
#pragma unroll
                for (int ks = 0; ks < 2; ++ks) {
                    const bf16x8 a_kd = *(const LAS bf16x8*)(kd + arow + ks * 32), a_st = *(const LAS bf16x8*)(stT + arow + ks * 32), a_kt = trfrag(ktT, 72, ks * 32, tr * 16, lane);
#pragma unroll
                    for (int t = 0; t < 2; ++t) { const int brow = ((tcb + t) * 16 + r16) * 72 + ks * 32 + quad * 8;
                        const bf16x8 b_qd = *(const LAS bf16x8*)(qd + brow), b_vT = trfrag(vT, 72, ks * 32, (tcb + t) * 16, lane);
                        sc[t] = __builtin_amdgcn_mfma_f32_16x16x32_bf16(a_kd, b_qd, sc[t], 0, 0, 0);
                        oacc[t] = __builtin_amdgcn_mfma_f32_16x16x32_bf16(a_st, b_qd, oacc[t], 0, 0, 0);
                        sacc[t] = __builtin_amdgcn_mfma_f32_16x16x32_bf16(a_kt, b_vT, sacc[t], 0, 0, 0); } }
#pragma unroll
                for (int t = 0; t < 2; ++t) { const int lrow = (tcb + t) * 16 + r16; float pv[4];
#pragma unroll
                    for (int j = 0; j < 4; ++j) { const int m = tr * 16 + quad * 4 + j; const bool keep = dir ? (lrow > m) : (lrow >= m); pv[j] = keep ? sc[t][j] : 0.f; }
                    u32x2 pw; pw.x = cvt_pk_bf16(pv[0], pv[1]); pw.y = cvt_pk_bf16(pv[2], pv[3]);
                    *(LAS u32x2*)(Pm + lrow * 72 + tr * 16 + quad * 4) = pw; } }
            LBAR();
            {
                const int arow = (tr * 16 + r16) * 72 + quad * 8;
#pragma unroll
                for (int ks = 0; ks < 2; ++ks) { const bf16x8 a_v = trfrag(vT, 72, ks * 32, tr * 16, lane);
#pragma unroll
                    for (int t = 0; t < 2; ++t) { const bf16x8 b_P = *(const LAS bf16x8*)(Pm + ((tcb + t) * 16 + r16) * 72 + ks * 32 + quad * 8);
                        oacc[t] = __builtin_amdgcn_mfma_f32_16x16x32_bf16(a_v, b_P, oacc[t], 0, 0, 0); } }
#pragma unroll
                for (int t = 0; t < 2; ++t) { const int cr = (tcb + t) * 16 + r16;
                    *(LAS f32x4*)(o_s + cr * 64 + tr * 16 + quad * 4) = oacc[t];
                    u32x2 sw; sw.x = cvt_pk_bf16(sacc[t][0], sacc[t][1]); sw.y = cvt_pk_bf16(sacc[t][2], sacc[t][3]);
                    *(LAS u32x2*)(stT + cr * 72 + tr * 16 + quad * 4) = sw; } }
            LBAR();
            {   float f[8];
#pragma unroll
                for (int j = 0; j < 8; ++j) f[j] = o_s[ltok * 64 + lc8 + j];
                *(uint4*)(O + (t0 + ltokm) * 512 + h * 128 + vh * 64 + lc8) = pack8(f); }
        }
    }
}

__device__ void gla_post_phase(const Params& p, int l) {
    const int gtid = BID() * 512 + TID(), gsz = NBLK() * 512;
    const bf16_t* ZG = (const bf16_t*)(WSP(p) + WS_R + R_ZG); bf16_t* OF = (bf16_t*)(WSP(p) + WS_Y); const bf16_t* OB = (const bf16_t*)(WSP(p) + WS_H);
    const float* gn = INP(p, 11) + (size_t)l * 512;
    for (int idx = gtid; idx < T_ * 64; idx += gsz) {
        const int sub = idx & 15, th = idx >> 4, h = th & 3; const size_t t = (size_t)(th >> 2); const int col = h * 128 + sub * 8;
        float of[8], ob[8], r[8], y[8];
        unpack8(*(const uint4*)(OF + t * 512 + col), of); unpack8(*(const uint4*)(OB + t * 512 + col), ob); unpack8(*(const uint4*)(ZG + t * ZGC + 1024 + col), r);
        float ss = 0.f;
#pragma unroll
        for (int j = 0; j < 8; ++j) { of[j] += ob[j]; ss += of[j] * of[j]; }
        ss = red16(ss);
        const float rs = rsqrtf(ss * (1.0f / 128.0f) + 1e-6f);
#pragma unroll
        for (int j = 0; j < 8; ++j) y[j] = of[j] * rs * gn[col + j] * (r[j] * sigmoid_(r[j]));
        *(uint4*)(OF + t * 512 + col) = pack8(y);
    }
}


struct RwOps { f32x4 w0, w1, c0, c1, e0, e1, d0, d1, r0, r1; float vv; };
__device__ __forceinline__ RwOps rw_load(const LAS float* w_s, int s, int v, int ko) {
    RwOps o; const LAS float* b = w_s + s * 64 + ko * 8;
    o.w0 = *(const LAS f32x4*)(b); o.w1 = *(const LAS f32x4*)(b + 4);
    o.c0 = *(const LAS f32x4*)(b + 2048); o.c1 = *(const LAS f32x4*)(b + 2052);
    o.e0 = *(const LAS f32x4*)(b + 4096); o.e1 = *(const LAS f32x4*)(b + 4100);
    o.d0 = *(const LAS f32x4*)(b + 6144); o.d1 = *(const LAS f32x4*)(b + 6148);
    o.r0 = *(const LAS f32x4*)(b + 8192); o.r1 = *(const LAS f32x4*)(b + 8196);
    o.vv = w_s[10240 + s * 64 + v]; return o;
}
typedef float f2v __attribute__((ext_vector_type(2)));
__device__ __forceinline__ float dot8(const f2v (&S)[4], const f32x4 a, const f32x4 b) {
    f2v acc = S[0] * (f2v){a[0], a[1]};
    acc = S[1] * (f2v){a[2], a[3]} + acc;
    acc = S[2] * (f2v){b[0], b[1]} + acc;
    acc = S[3] * (f2v){b[2], b[3]} + acc;
    return acc.x + acc.y;
}
template <int DIR> __device__ __forceinline__ void rw_step(f2v (&S)[4], const RwOps& p, LAS float* y_s, int s, int v) {
    float y = 0.f;
    if (DIR) y = dot8(S, p.r0, p.r1);
    const float sa = -red8(dot8(S, p.c0, p.c1));
    const f2v sa2 = {sa, sa}, vv2 = {p.vv, p.vv};
    S[0] = S[0] * (f2v){p.w0[0], p.w0[1]} + ((f2v){p.e0[0], p.e0[1]} * sa2 + (f2v){p.d0[0], p.d0[1]} * vv2);
    S[1] = S[1] * (f2v){p.w0[2], p.w0[3]} + ((f2v){p.e0[2], p.e0[3]} * sa2 + (f2v){p.d0[2], p.d0[3]} * vv2);
    S[2] = S[2] * (f2v){p.w1[0], p.w1[1]} + ((f2v){p.e1[0], p.e1[1]} * sa2 + (f2v){p.d1[0], p.d1[1]} * vv2);
    S[3] = S[3] * (f2v){p.w1[2], p.w1[3]} + ((f2v){p.e1[2], p.e1[3]} * sa2 + (f2v){p.d1[2], p.d1[3]} * vv2);
    if (!DIR) y = dot8(S, p.r0, p.r1);
    y = red8(y);
    y_s[s * 64 + v] = y;
}
template <int DIR> __device__ __forceinline__ void rwkv_steps(f2v (&S)[4], LAS float* w_s, int v, int ko) {
    LAS float* y_s = w_s + 12288;
    RwOps a = rw_load(w_s, DIR ? 31 : 0, v, ko);
#pragma unroll 1
    for (int si = 0; si < 32; si += 2) {
        const int s0 = DIR ? 31 - si : si, s1 = DIR ? 30 - si : si + 1, s2 = DIR ? (si < 30 ? 29 - si : 0) : (si < 30 ? si + 2 : 31);
        const RwOps b = rw_load(w_s, s1, v, ko);
        rw_step<DIR>(S, a, y_s, s0, v);
        a = rw_load(w_s, s2, v, ko);
        rw_step<DIR>(S, b, y_s, s1, v);
    }
}

__device__ __forceinline__ int rwkv_col(int cg, int h, int dir) {
    if (cg < 4) return h * 64 + cg * 16;
    if (cg < 8) return 512 + h * 64 + (cg - 4) * 16;
    if (cg < 12) return 1024 + h * 64 + (cg - 8) * 16;
    if (cg < 14) return (dir ? 1568 : 1536) + (cg - 12) * 16;
    return (dir ? 1632 : 1600) + (cg - 14) * 16;
}
__device__ void rwkv_scan_phase(const Params& p, int l, LAS unsigned char* lds) {
    const int tid = TID();
    const bf16_t* ZR = (const bf16_t*)(WSP(p) + WS_R + R_ZR);
    float* BON = (float*)(WSP(p) + WS_BON);
    LAS float* sh_s = (LAS float*)lds;
    LAS float* w_s = sh_s + 8192; LAS float* kk_s = w_s + 2048; LAS float* kka_s = kk_s + 2048; LAS float* kd_s = kka_s + 2048; LAS float* r_s = kd_s + 2048; LAS float* v_s = r_s + 2048;
    LAS float* y_s = v_s + 2048; LAS float* w2_s = y_s + 2048; LAS float* a2_s = w2_s + 2048; LAS float* c_s = a2_s + 2048; LAS float* mu_s = c_s + 320;
    const float* mu = INP(p, 12) + (size_t)l * ZRC;
    for (int w = BID(); w < 256; w += NBLK()) {
        const int dir = w & 1, h = (w >> 1) & 7, b = w >> 4;
        const float* w0 = (dir ? INP(p, 15) : INP(p, 13)) + (size_t)l * 512; const float* w2 = (dir ? INP(p, 16) : INP(p, 14)) + (size_t)l * 32 * 512;
        const float* a0 = (dir ? INP(p, 19) : INP(p, 17)) + (size_t)l * 512; const float* a2 = (dir ? INP(p, 20) : INP(p, 18)) + (size_t)l * 32 * 512;
        bf16_t* Y = dir ? (bf16_t*)(WSP(p) + WS_R + R_FT) : (bf16_t*)(WSP(p) + WS_Y + 2 * Y_STRIDE);
        const int tok = tid >> 4, cg = tid & 15, zc = rwkv_col(cg, h, dir);
        __syncthreads();
        for (int i = tid; i < 2048; i += 512) { w2_s[i] = w2[(i >> 6) * 512 + h * 64 + (i & 63)]; a2_s[i] = a2[(i >> 6) * 512 + h * 64 + (i & 63)]; }
        if (tid < 64) { c_s[tid] = w0[h * 64 + tid]; c_s[64 + tid] = a0[h * 64 + tid]; c_s[128 + tid] = INP(p, 22)[(size_t)l * 512 + h * 64 + tid];
                        c_s[192 + tid] = INP(p, 23)[(size_t)l * 512 + h * 64 + tid]; c_s[256 + tid] = INP(p, 24)[(size_t)l * 512 + h * 64 + tid]; }
        if (tid < 256) mu_s[tid] = mu[rwkv_col(tid >> 4, h, dir) + (tid & 15)];
        f2v S[4];
#pragma unroll
        for (int j = 0; j < 4; ++j) S[j] = (f2v){0.f, 0.f};
        const int v = tid >> 3, ko = tid & 7;
        uint4 rp[2], rc[2], rn[2];
#define RW_LOAD(cidx) do { const int s_ = (cidx) * 32 + tok; const bf16_t* zp = ZR + ((size_t)b * SEQ_ + s_) * ZRC + zc; \
            rc[0] = *(const uint4*)zp; rc[1] = *(const uint4*)(zp + 8); \
            if (s_ > 0) { rp[0] = *(const uint4*)(zp - ZRC); rp[1] = *(const uint4*)(zp - ZRC + 8); } else { rp[0] = make_uint4(0, 0, 0, 0); rp[1] = rp[0]; } \
            if (s_ < SEQ_ - 1) { rn[0] = *(const uint4*)(zp + ZRC); rn[1] = *(const uint4*)(zp + ZRC + 8); } else { rn[0] = make_uint4(0, 0, 0, 0); rn[1] = rn[0]; } } while (0)
        RW_LOAD(dir ? 63 : 0);
        for (int ci = 0; ci < 64; ++ci) {
            const int c = dir ? 63 - ci : ci; const size_t t0 = (size_t)b * SEQ_ + c * 32;
            __syncthreads();
#pragma unroll
            for (int hf = 0; hf < 2; ++hf) { float fc[8], fp[8], fn[8]; unpack8(rc[hf], fc); unpack8(rp[hf], fp); unpack8(rn[hf], fn);
#pragma unroll
                for (int j = 0; j < 8; ++j) { const int vc = cg * 16 + hf * 8 + j; float x = fc[j] + mu_s[vc] * (0.5f * (fp[j] + fn[j]) - fc[j]);
                    if (cg == 12 || cg == 13) x = tanh_(x);
                    sh_s[tok * 256 + vc] = x; } }
            __syncthreads();
            {
                const int j0 = cg * 4;
                float wp[4], ap[4];
#pragma unroll
                for (int j = 0; j < 4; ++j) { wp[j] = c_s[j0 + j]; ap[j] = c_s[64 + j0 + j]; }
#pragma unroll 8
                for (int i = 0; i < 32; ++i) { const float tw = sh_s[tok * 256 + 192 + i], ta = sh_s[tok * 256 + 224 + i];
                    const f32x4 w2v = *(const LAS f32x4*)(w2_s + i * 64 + j0), a2v = *(const LAS f32x4*)(a2_s + i * 64 + j0);
#pragma unroll
                    for (int j = 0; j < 4; ++j) { wp[j] += tw * w2v[j]; ap[j] += ta * a2v[j]; } }
                f32x4 rv4 = *(const LAS f32x4*)(sh_s + tok * 256 + j0), kv4 = *(const LAS f32x4*)(sh_s + tok * 256 + 64 + j0), vv4 = *(const LAS f32x4*)(sh_s + tok * 256 + 128 + j0);
                f32x4 wv, kkv, kkav, kdv; float ss = 0.f, bs = 0.f;
#pragma unroll
                for (int j = 0; j < 4; ++j) { kkv[j] = kv4[j] * c_s[128 + j0 + j]; ss += kkv[j] * kkv[j]; }
                ss = red16(ss);
                const float rn_ = rsqrtf(ss + 1e-12f);
#pragma unroll
                for (int j = 0; j < 4; ++j) {
                    const float a = sigmoid_(ap[j]);
                    wv[j] = __expf(-__expf(-softplus_(-wp[j]) - 0.5f));
                    kkv[j] *= rn_; kkav[j] = kkv[j] * a;
                    kdv[j] = kv4[j] * (1.0f + (a - 1.0f) * c_s[192 + j0 + j]);
                    bs += rv4[j] * kdv[j] * c_s[256 + j0 + j];
                }
                bs = red16(bs);
                if (dir == 0 && cg == 0) BON[(t0 + tok) * 8 + h] = bs;
                *(LAS f32x4*)(w_s + tok * 64 + j0) = wv; *(LAS f32x4*)(kk_s + tok * 64 + j0) = kkv; *(LAS f32x4*)(kka_s + tok * 64 + j0) = kkav;
                *(LAS f32x4*)(kd_s + tok * 64 + j0) = kdv; *(LAS f32x4*)(r_s + tok * 64 + j0) = rv4; *(LAS f32x4*)(v_s + tok * 64 + j0) = vv4;
            }
            if (ci + 1 < 64) { RW_LOAD(dir ? 62 - ci : ci + 1); }
            __syncthreads();
            if (dir) rwkv_steps<1>(S, w_s, v, ko); else rwkv_steps<0>(S, w_s, v, ko);
            __syncthreads();
            {   const f32x4 yv = *(const LAS f32x4*)(y_s + tok * 64 + cg * 4);
                u32x2 wv2; wv2.x = cvt_pk_bf16(yv[0], yv[1]); wv2.y = cvt_pk_bf16(yv[2], yv[3]);
                *(u32x2*)(Y + (t0 + tok) * 512 + h * 64 + cg * 4) = wv2; }
        }
#undef RW_LOAD
    }
}


__device__ void rwkv_chunk_phase(const Params& p, int l, LAS unsigned char* lds) {
    const int tid = TID(), lane = tid & 63, wid = tid >> 6, r16 = lane & 15, quad = lane >> 4;
    const bf16_t* ZR = (const bf16_t*)(WSP(p) + WS_R + R_ZR);
    float* BON = (float*)(WSP(p) + WS_BON);
    LAS bf16_t* w2T = (LAS bf16_t*)lds; LAS bf16_t* a2T = w2T + 2560; LAS float* c_s = (LAS float*)(lds + 16384); LAS float* mu_s = c_s + 320; LAS float* gL_s = mu_s + 256; LAS float* part_s = gL_s + 64;
    LAS float* lg_s = (LAS float*)(lds + 20992); LAS float* y_s = (LAS float*)(lds + 29184);
    LAS bf16_t* S0b[2] = {(LAS bf16_t*)(lds + 37376), (LAS bf16_t*)(lds + 46592)};
    LAS bf16_t* G1 = (LAS bf16_t*)(lds + 55808);
    LAS bf16_t* Ct = (LAS bf16_t*)(lds + 65024); LAS bf16_t* Bt = Ct + 2304; LAS bf16_t* Kt = Bt + 2304; LAS bf16_t* Rt = Kt + 2304; LAS bf16_t* B1 = Rt + 2304;
    LAS bf16_t* CtT = (LAS bf16_t*)(lds + 88064); LAS bf16_t* BgT = CtT + 2560; LAS bf16_t* KgT = BgT + 2560; LAS bf16_t* VtT = KgT + 2560; LAS bf16_t* W2 = VtT + 2560; LAS bf16_t* G2m = W2 + 2560;
    LAS float* sh_s = (LAS float*)(lds + 118784);
    LAS bf16_t* Pq[2] = {(LAS bf16_t*)(lds + 118784), (LAS bf16_t*)(lds + 118784 + 5120)}; LAS bf16_t* PTq[2] = {Pq[0] + 1280, Pq[1] + 1280};
    LAS bf16_t* Tq[2] = {(LAS bf16_t*)(lds + 118784 + 10240), (LAS bf16_t*)(lds + 118784 + 12800)};
    LAS bf16_t* TT = (LAS bf16_t*)(lds + 118784 + 15360); LAS bf16_t* QTT = TT + 1280; LAS bf16_t* MKT = QTT + 1280; LAS bf16_t* MBT = MKT + 1280; LAS bf16_t* W1 = MBT + 1280; LAS bf16_t* B2 = W1 + 1280;
    LAS float* lgp_s = (LAS float*)(lds + 55808);
    LAS bf16_t* lwT_hi = (LAS bf16_t*)(lds + 113664); LAS bf16_t* lwT_lo = CtT;
    LAS bf16_t* L32 = (LAS bf16_t*)(lds + 83456); LAS float* tot_s = part_s;
    const float* mu = INP(p, 12) + (size_t)l * ZRC;
    for (int w = BID(); w < 256; w += NBLK()) {
        const int dir = w & 1, h = (w >> 1) & 7, b = w >> 4;
        const float* w0 = (dir ? INP(p, 15) : INP(p, 13)) + (size_t)l * 512; const float* w2 = (dir ? INP(p, 16) : INP(p, 14)) + (size_t)l * 32 * 512;
        const float* a0 = (dir ? INP(p, 19) : INP(p, 17)) + (size_t)l * 512; const float* a2 = (dir ? INP(p, 20) : INP(p, 18)) + (size_t)l * 32 * 512;
        bf16_t* Y = dir ? (bf16_t*)(WSP(p) + WS_R + R_FT) : (bf16_t*)(WSP(p) + WS_Y + 2 * Y_STRIDE);
        const int tok = tid >> 4, cg = tid & 15, zc = rwkv_col(cg, h, dir), j0 = cg * 4;
        const int tokm = dir ? 31 - tok : tok;
        __syncthreads();
        for (int i = tid; i < 2048; i += 512) { const int ii = i >> 6, jj = i & 63; st_bf(w2T + jj * 40 + ii, w2[ii * 512 + h * 64 + jj]); st_bf(a2T + jj * 40 + ii, a2[ii * 512 + h * 64 + jj]); }
        if (tid < 64) { c_s[tid] = w0[h * 64 + tid]; c_s[64 + tid] = a0[h * 64 + tid]; c_s[128 + tid] = INP(p, 22)[(size_t)l * 512 + h * 64 + tid];
                        c_s[192 + tid] = INP(p, 23)[(size_t)l * 512 + h * 64 + tid]; c_s[256 + tid] = INP(p, 24)[(size_t)l * 512 + h * 64 + tid]; }
        if (tid < 256) mu_s[tid] = mu[rwkv_col(tid >> 4, h, dir) + (tid & 15)];
        for (int i = tid; i < 2304; i += 512) ((LAS unsigned*)S0b[0])[i] = 0u;
        for (int i = tid; i < 32 * 40; i += 512) { const int t = i / 40, ii = i - t * 40; st_bf(L32 + i, (ii <= t && ii < 32) ? 1.0f : 0.f); }
        uint4 rp[2], rc[2], rn[2];
#define RW_LOAD(cidx) do { const int s_ = (cidx) * 32 + tokm; const bf16_t* zp = ZR + ((size_t)b * SEQ_ + s_) * ZRC + zc; \
            rc[0] = *(const uint4*)zp; rc[1] = *(const uint4*)(zp + 8); \
            if (s_ > 0) { rp[0] = *(const uint4*)(zp - ZRC); rp[1] = *(const uint4*)(zp - ZRC + 8); } else { rp[0] = make_uint4(0, 0, 0, 0); rp[1] = rp[0]; } \
            if (s_ < SEQ_ - 1) { rn[0] = *(const uint4*)(zp + ZRC); rn[1] = *(const uint4*)(zp + ZRC + 8); } else { rn[0] = make_uint4(0, 0, 0, 0); rn[1] = rn[0]; } } while (0)
        RW_LOAD(dir ? 63 : 0);
        int cur = 0;
#pragma unroll 1
        for (int ci = 0; ci < 64; ++ci) {
            const int c = dir ? 63 - ci : ci; const size_t t0 = (size_t)b * SEQ_ + c * 32;
            LBAR();
            f32x4 lw4, kk4, b4, kd4, r4, v4;
            for (int rp_ = 0; rp_ < STG_REP; ++rp_) {
            if (rp_) LBAR();
#pragma unroll
            for (int hf = 0; hf < 2; ++hf) { float fc[8], fp[8], fn[8]; unpack8(rc[hf], fc); unpack8(rp[hf], fp); unpack8(rn[hf], fn);
                const f32x4 m0 = *(const LAS f32x4*)(mu_s + cg * 16 + hf * 8), m1 = *(const LAS f32x4*)(mu_s + cg * 16 + hf * 8 + 4);
                f32x4 x0, x1;
#pragma unroll
                for (int j = 0; j < 4; ++j) { x0[j] = fc[j] + m0[j] * (0.5f * (fp[j] + fn[j]) - fc[j]); x1[j] = fc[4 + j] + m1[j] * (0.5f * (fp[4 + j] + fn[4 + j]) - fc[4 + j]); }
                *(LAS f32x4*)(sh_s + tok * 256 + cg * 16 + hf * 8) = x0; *(LAS f32x4*)(sh_s + tok * 256 + cg * 16 + hf * 8 + 4) = x1; }
            LBAR();
            {   const int rt = wid >> 2, ct = wid & 3, row = rt * 16 + r16;
                const f32x4 d0 = *(const LAS f32x4*)(sh_s + row * 256 + 192 + quad * 8), d1 = *(const LAS f32x4*)(sh_s + row * 256 + 196 + quad * 8);
                const f32x4 e0 = *(const LAS f32x4*)(sh_s + row * 256 + 224 + quad * 8), e1 = *(const LAS f32x4*)(sh_s + row * 256 + 228 + quad * 8);
                u32x4 aw, aa;
                aw.x = cvt_pk_bf16(tanh_(d0[0]), tanh_(d0[1])); aw.y = cvt_pk_bf16(tanh_(d0[2]), tanh_(d0[3])); aw.z = cvt_pk_bf16(tanh_(d1[0]), tanh_(d1[1])); aw.w = cvt_pk_bf16(tanh_(d1[2]), tanh_(d1[3]));
                aa.x = cvt_pk_bf16(e0[0], e0[1]); aa.y = cvt_pk_bf16(e0[2], e0[3]); aa.z = cvt_pk_bf16(e1[0], e1[1]); aa.w = cvt_pk_bf16(e1[2], e1[3]);
                const bf16x8 bw = *(const LAS bf16x8*)(w2T + (ct * 16 + r16) * 40 + quad * 8), ba = *(const LAS bf16x8*)(a2T + (ct * 16 + r16) * 40 + quad * 8);
                const f32x4 z4 = {0.f, 0.f, 0.f, 0.f};
                const f32x4 cw = __builtin_amdgcn_mfma_f32_16x16x32_bf16(__builtin_bit_cast(bf16x8, aw), bw, z4, 0, 0, 0);
                const f32x4 ca = __builtin_amdgcn_mfma_f32_16x16x32_bf16(__builtin_bit_cast(bf16x8, aa), ba, z4, 0, 0, 0);
                const int col = ct * 16 + r16; const float w0c = c_s[col], a0c = c_s[64 + col];
                f32x4 lwv, lo;
#pragma unroll
                for (int j = 0; j < 4; ++j) { const int tr_ = rt * 16 + quad * 4 + j; lwv[j] = -__expf(-softplus_(-(cw[j] + w0c)) - 0.5f); y_s[tr_ * 64 + col] = lwv[j]; lg_s[tr_ * 64 + col] = ca[j] + a0c; }
                const unsigned h01 = cvt_pk_bf16(lwv[0], lwv[1]), h23 = cvt_pk_bf16(lwv[2], lwv[3]);
                lo[0] = lwv[0] - bf_lo(h01); lo[1] = lwv[1] - bf_hi(h01); lo[2] = lwv[2] - bf_lo(h23); lo[3] = lwv[3] - bf_hi(h23);
                u32x2 hw; hw.x = h01; hw.y = h23; *(LAS u32x2*)(lwT_hi + col * 40 + rt * 16 + quad * 4) = hw; st_bf4(lwT_lo + col * 40 + rt * 16 + quad * 4, lo); }
            LBAR();
            {   const f32x4 wp = *(const LAS f32x4*)(y_s + tok * 64 + j0), ap = *(const LAS f32x4*)(lg_s + tok * 64 + j0);
                r4 = *(const LAS f32x4*)(sh_s + tok * 256 + j0); const f32x4 kv4 = *(const LAS f32x4*)(sh_s + tok * 256 + 64 + j0); v4 = *(const LAS f32x4*)(sh_s + tok * 256 + 128 + j0);
                float ss = 0.f, bs = 0.f;
#pragma unroll
                for (int j = 0; j < 4; ++j) { kk4[j] = kv4[j] * c_s[128 + j0 + j]; ss += kk4[j] * kk4[j]; }
                ss = red16d(ss);
                const float rn_ = rsqrtf(ss + 1e-12f);
#pragma unroll
                for (int j = 0; j < 4; ++j) {
                    const float a = sigmoid_(ap[j]);
                    lw4[j] = wp[j];
                    kk4[j] *= rn_; b4[j] = kk4[j] * a;
                    kd4[j] = kv4[j] * (1.0f + (a - 1.0f) * c_s[192 + j0 + j]);
                    bs += r4[j] * kd4[j] * c_s[256 + j0 + j];
                }
                bs = red16d(bs);
                if (dir == 0 && cg == 0) BON[(t0 + tokm) * 8 + h] = bs;
            }
            {
                const int rt = wid >> 2, ct = wid & 3; const f32x4 z4 = {0.f, 0.f, 0.f, 0.f};
                f32x4 acc = mm_nt<1>(L32, 40, rt * 16, lwT_hi, 40, ct * 16, r16, quad, z4);
                acc = mm_nt<1>(L32, 40, rt * 16, lwT_lo, 40, ct * 16, r16, quad, acc);
                const int col = ct * 16 + r16;
#pragma unroll
                for (int j = 0; j < 4; ++j) lgp_s[(rt * 16 + quad * 4 + j) * 64 + col] = acc[j];
                if (rt == 1 && quad == 3) { tot_s[col] = acc[3]; gL_s[col] = __expf(acc[3]); } }
            if (ci + 1 < 64 && rp_ == STG_REP - 1) { RW_LOAD(dir ? 62 - ci : ci + 1); }
            LBAR();
            {   const f32x4 lgl = *(const LAS f32x4*)(lgp_s + tok * 64 + j0), tot = *(const LAS f32x4*)(tot_s + j0);
                f32x4 ctv, btv, ktv, rtv, bgv, kgv;
#pragma unroll
                for (int j = 0; j < 4; ++j) {
                    const float lg = lgl[j], lgp = lg - lw4[j];
                    const float einv = __expf(-lg), eL = __expf(tot[j] - lg);
                    ctv[j] = kk4[j] * __expf(lgp); btv[j] = b4[j] * einv; ktv[j] = kd4[j] * einv; rtv[j] = r4[j] * __expf(dir ? lgp : lg);
                    bgv[j] = b4[j] * eL; kgv[j] = kd4[j] * eL;
                }
                st_bf4(Ct + tok * 72 + j0, ctv); st_bf4(Bt + tok * 72 + j0, btv); st_bf4(Kt + tok * 72 + j0, ktv); st_bf4(Rt + tok * 72 + j0, rtv);
                st_bf4(BgT + tok * 72 + j0, bgv); st_bf4(KgT + tok * 72 + j0, kgv); st_bf4(VtT + tok * 72 + j0, v4);
            }
            }
            LBAR();
#pragma unroll
            for (int i = 0; i < 2; ++i) { const int id = wid + 8 * i, pr = id >> 2, rt = (id >> 1) & 1, ct = id & 1;
                const LAS bf16_t* X = (pr < 2) ? Ct : Rt; const LAS bf16_t* Yo = (pr == 0 || pr == 3) ? Bt : Kt;
                const f32x4 z4 = {0.f, 0.f, 0.f, 0.f};
                f32x4 acc = mm_nt<2>(X, 72, rt * 16, Yo, 72, ct * 16, r16, quad, z4);
                const int col = ct * 16 + r16, rb = rt * 16 + quad * 4;
                const bool strictm = (pr < 2) || dir;
#pragma unroll
                for (int j = 0; j < 4; ++j) { const int row = rb + j; const bool keep = strictm ? (row > col) : (row >= col); acc[j] = keep ? acc[j] : 0.f; }
                if (pr == 0) { f32x4 t0v;
#pragma unroll
                    for (int j = 0; j < 4; ++j) t0v[j] = ((rb + j) == col ? 1.0f : 0.0f) - acc[j];
                    const f32x4 na = -acc; st_bf4(PTq[0] + col * 40 + rb, na); st_bf4(Tq[0] + col * 40 + rb, t0v); }
                else { LAS bf16_t* D = (pr == 1) ? QTT : ((pr == 2) ? MKT : MBT); st_bf4(D + col * 40 + rb, acc); } }
            LBAR();
            {   const int rt = wid >> 2, ct = wid & 3; const f32x4 z4 = {0.f, 0.f, 0.f, 0.f};
                f32x4 acc = mm_nt<2>(Ct, 72, rt * 16, S0b[cur], 72, ct * 16, r16, quad, z4);
                acc = __builtin_amdgcn_mfma_f32_16x16x32_bf16(trfrag(QTT, 40, 0, rt * 16, lane), trfrag(VtT, 72, 0, ct * 16, lane), acc, 0, 0, 0);
                st_bf4(CtT + (ct * 16 + r16) * 40 + rt * 16 + quad * 4, acc); }
            if (wid < 4) { const int rt = wid >> 1, ct = wid & 1; const f32x4 z4 = {0.f, 0.f, 0.f, 0.f};
                const f32x4 acc = __builtin_amdgcn_mfma_f32_16x16x32_bf16(trfrag(PTq[0], 40, 0, rt * 16, lane), *(const LAS bf16x8*)(PTq[0] + (ct * 16 + r16) * 40 + quad * 8), z4, 0, 0, 0);
                st_bf4(PTq[1] + (ct * 16 + r16) * 40 + rt * 16 + quad * 4, acc); }
            LBAR();
#pragma unroll
            for (int st = 0; st < 3; ++st) { const int pi = (st & 1) ? 0 : 1, ti = st & 1;
                const int rt = (wid >> 1) & 1, ct = wid & 1; const f32x4 z4 = {0.f, 0.f, 0.f, 0.f};
                const int col = ct * 16 + r16, rb = rt * 16 + quad * 4;
                const bf16x8 yb = *(const LAS bf16x8*)(PTq[pi] + col * 40 + quad * 8);
                if (wid < 4) { const f32x4 acc = __builtin_amdgcn_mfma_f32_16x16x32_bf16(trfrag(PTq[pi], 40, 0, rt * 16, lane), yb, z4, 0, 0, 0);
                    st_bf4(PTq[pi ^ 1] + col * 40 + rb, acc); }
                else { f32x4 acc = __builtin_amdgcn_mfma_f32_16x16x32_bf16(trfrag(Tq[ti], 40, 0, rt * 16, lane), yb, z4, 0, 0, 0);
                    const u32x2 tw = *(const LAS u32x2*)(Tq[ti] + col * 40 + rb);
                    acc[0] += bf_lo(tw.x); acc[1] += bf_hi(tw.x); acc[2] += bf_lo(tw.y); acc[3] += bf_hi(tw.y);
                    st_bf4(Tq[ti ^ 1] + col * 40 + rb, acc); }
                LBAR(); }
            if (wid < 4) { const int rt = wid >> 1, ct = wid & 1; const f32x4 z4 = {0.f, 0.f, 0.f, 0.f};
                const int col = ct * 16 + r16, rb = rt * 16 + quad * 4;
                f32x4 acc = __builtin_amdgcn_mfma_f32_16x16x32_bf16(trfrag(Tq[1], 40, 0, rt * 16, lane), *(const LAS bf16x8*)(PTq[0] + col * 40 + quad * 8), z4, 0, 0, 0);
                const u32x2 tw = *(const LAS u32x2*)(Tq[1] + col * 40 + rb);
                acc[0] += bf_lo(tw.x); acc[1] += bf_hi(tw.x); acc[2] += bf_lo(tw.y); acc[3] += bf_hi(tw.y);
                st_bf4(TT + col * 40 + rb, acc); }
            LBAR();
            {   const int rt = wid >> 2, ct = wid & 3; const f32x4 z4 = {0.f, 0.f, 0.f, 0.f};
                const f32x4 acc = __builtin_amdgcn_mfma_f32_16x16x32_bf16(trfrag(TT, 40, 0, rt * 16, lane), *(const LAS bf16x8*)(CtT + (ct * 16 + r16) * 40 + quad * 8), z4, 0, 0, 0);
                const f32x4 na = -acc; st_bf4(W2 + (ct * 16 + r16) * 40 + rt * 16 + quad * 4, na); }
            LBAR();
            {   const LAS bf16_t* S0 = S0b[cur]; LAS bf16_t* S1 = S0b[cur ^ 1];
#pragma unroll
                for (int i = 0; i < 3; ++i) { const int id = wid + 8 * i; const f32x4 z4 = {0.f, 0.f, 0.f, 0.f};
                    if (id < 8) { const int rt = id >> 2, ct = id & 3;
                        f32x4 acc = mm_nt<2>(Rt, 72, rt * 16, S0, 72, ct * 16, r16, quad, z4);
                        acc = __builtin_amdgcn_mfma_f32_16x16x32_bf16(trfrag(MKT, 40, 0, rt * 16, lane), trfrag(VtT, 72, 0, ct * 16, lane), acc, 0, 0, 0);
                        acc = __builtin_amdgcn_mfma_f32_16x16x32_bf16(trfrag(MBT, 40, 0, rt * 16, lane), *(const LAS bf16x8*)(W2 + (ct * 16 + r16) * 40 + quad * 8), acc, 0, 0, 0);
#pragma unroll
                        for (int j = 0; j < 4; ++j) y_s[(rt * 16 + quad * 4 + j) * 64 + ct * 16 + r16] = acc[j]; }
                    else { const int t = id - 8, rt = t >> 2, ct = t & 3;
                        f32x4 acc = __builtin_amdgcn_mfma_f32_16x16x32_bf16(trfrag(KgT, 72, 0, rt * 16, lane), trfrag(VtT, 72, 0, ct * 16, lane), z4, 0, 0, 0);
                        acc = __builtin_amdgcn_mfma_f32_16x16x32_bf16(trfrag(BgT, 72, 0, rt * 16, lane), *(const LAS bf16x8*)(W2 + (ct * 16 + r16) * 40 + quad * 8), acc, 0, 0, 0);
                        const int kb = rt * 16 + quad * 4, vv_ = ct * 16 + r16;
                        const f32x4 gl = *(const LAS f32x4*)(gL_s + kb);
                        const u32x2 sw = *(const LAS u32x2*)(S0 + vv_ * 72 + kb);
                        acc[0] += gl[0] * bf_lo(sw.x); acc[1] += gl[1] * bf_hi(sw.x); acc[2] += gl[2] * bf_lo(sw.y); acc[3] += gl[3] * bf_hi(sw.y);
                        st_bf4(S1 + vv_ * 72 + kb, acc); } }
                cur ^= 1; }
            LBAR();
            {   const f32x4 yv = *(const LAS f32x4*)(y_s + tok * 64 + cg * 4);
                u32x2 wv2; wv2.x = cvt_pk_bf16(yv[0], yv[1]); wv2.y = cvt_pk_bf16(yv[2], yv[3]);
                *(u32x2*)(Y + (t0 + tokm) * 512 + h * 64 + cg * 4) = wv2; }
        }
#undef RW_LOAD
    }
}

__device__ void rwkv_post_phase(const Params& p, int l, LAS unsigned char* lds) {
    const int tid = TID();
    const bf16_t* ZR = (const bf16_t*)(WSP(p) + WS_R + R_ZR); const float* BON = (const float*)(WSP(p) + WS_BON);
    bf16_t* YF = (bf16_t*)(WSP(p) + WS_Y + 2 * Y_STRIDE); const bf16_t* YBk = (const bf16_t*)(WSP(p) + WS_R + R_FT);
    const float* mu = INP(p, 12) + (size_t)l * ZRC; const float* g2 = INP(p, 21) + (size_t)l * 96 * 512;
    const float* lng = INP(p, 25) + (size_t)l * 512; const float* lnb = INP(p, 26) + (size_t)l * 512;
    const int lane = tid & 63, wid = tid >> 6, r16 = lane & 15, quad = lane >> 4;
    LAS bf16_t* g2T = (LAS bf16_t*)lds;
    LAS bf16_t* sgb = g2T + 512 * 104;
    LAS float* gs = (LAS float*)(lds + 133120);
    __syncthreads();
    for (int idx = tid; idx < 96 * 512; idx += 512) { const int i = idx >> 9, c = idx & 511; st_bf(g2T + c * 104 + i, g2[idx]); }
    for (int base = BID(); base < T_ / 64; base += 2 * NBLK()) {
        const int ntl = (base + NBLK() < T_ / 64) ? 2 : 1;
        __syncthreads();
        for (int tl = 0; tl < ntl; ++tl) {
            const size_t t0 = (size_t)(base + tl * NBLK()) * 64;
            for (int idx = tid; idx < 64 * 96; idx += 512) {
                const int tk = idx / 96, c = idx - tk * 96; const size_t t = t0 + tk; const int s = (int)(t & (SEQ_ - 1));
                const bf16_t* zp = ZR + t * ZRC + 1664 + c;
                const float uc = bf1(zp[0]), up_ = (s > 0) ? bf1(zp[-ZRC]) : 0.f, un = (s < SEQ_ - 1) ? bf1(zp[ZRC]) : 0.f;
                st_bf(sgb + tl * 6656 + tk * 104 + c, sigmoid_(uc + mu[1664 + c] * (0.5f * (up_ + un) - uc)));
            }
        }
        const int tp = tid >> 4, cg = tid & 15;
        for (int h = 0; h < 8; ++h) {
            const int c = h * 64 + cg * 4;
            const f32x4 lg = *(const f32x4*)(lng + c), lb = *(const f32x4*)(lnb + c), m4 = *(const f32x4*)(mu + 1024 + c);
            for (int tl = 0; tl < ntl; ++tl) {
                const size_t t0 = (size_t)(base + tl * NBLK()) * 64;
                __syncthreads();
#pragma unroll
                for (int i = 0; i < 2; ++i) { const int id = wid + 8 * i, rt = id >> 2, ct = id & 3; const f32x4 z4 = {0.f, 0.f, 0.f, 0.f};
                    const f32x4 acc = mm_nt<3>(sgb + tl * 6656, 104, rt * 16, g2T + h * 64 * 104, 104, ct * 16, r16, quad, z4);
#pragma unroll
                    for (int j = 0; j < 4; ++j) gs[(rt * 16 + quad * 4 + j) * 64 + ct * 16 + r16] = acc[j]; }
                __syncthreads();
                const f32x4 gA = *(const LAS f32x4*)(gs + tp * 64 + cg * 4), gB = *(const LAS f32x4*)(gs + (tp + 32) * 64 + cg * 4);
#pragma unroll
                for (int which = 0; which < 2; ++which) {
                    const size_t t = t0 + tp + which * 32; const int s = (int)(t & (SEQ_ - 1));
                    const u32x2 yfr = *(const u32x2*)(YF + t * 512 + c), ybr = *(const u32x2*)(YBk + t * 512 + c);
                    f32x4 y; y[0] = bf_lo(yfr.x) + bf_lo(ybr.x); y[1] = bf_hi(yfr.x) + bf_hi(ybr.x); y[2] = bf_lo(yfr.y) + bf_lo(ybr.y); y[3] = bf_hi(yfr.y) + bf_hi(ybr.y);
                    const float mean = red16d(y[0] + y[1] + y[2] + y[3]) * (1.0f / 64.0f);
                    const f32x4 d = y - mean;
                    const float var = red16d(d[0] * d[0] + d[1] * d[1] + d[2] * d[2] + d[3] * d[3]) * (1.0f / 64.0f);
                    const float rs = rsqrtf(var + 64e-5f);
                    const bf16_t* zp = ZR + t * ZRC + 1024 + c;
                    const u32x2 vc = *(const u32x2*)zp; u32x2 vp = {0u, 0u}, vn = {0u, 0u};
                    if (s > 0) vp = *(const u32x2*)(zp - ZRC);
                    if (s < SEQ_ - 1) vn = *(const u32x2*)(zp + ZRC);
                    f32x4 vcur, vprev, vnext;
                    vcur[0] = bf_lo(vc.x); vcur[1] = bf_hi(vc.x); vcur[2] = bf_lo(vc.y); vcur[3] = bf_hi(vc.y);
                    vprev[0] = bf_lo(vp.x); vprev[1] = bf_hi(vp.x); vprev[2] = bf_lo(vp.y); vprev[3] = bf_hi(vp.y);
                    vnext[0] = bf_lo(vn.x); vnext[1] = bf_hi(vn.x); vnext[2] = bf_lo(vn.y); vnext[3] = bf_hi(vn.y);
                    const f32x4 vs = vcur + m4 * ((vprev + vnext) * 0.5f - vcur);
                    const float bon = BON[t * 8 + h];
                    const f32x4 gg = which ? gB : gA;
                    const f32x4 o = (d * rs * lg + lb + vs * bon) * gg;
                    u32x2 ow; ow.x = cvt_pk_bf16(o[0], o[1]); ow.y = cvt_pk_bf16(o[2], o[3]);
                    *(u32x2*)(YF + t * 512 + c) = ow;
                }
            }
        }
    }
}

#define XB_TMO      128
#define XB_XCNT(j)  (256  + 64 * (j))
#define XB_XSUB(j)  (1280 + 64 * (j))
#define XB_XGEN(j)  (2304 + 64 * (j))
#define XB_TOP      3328
#define XB_TOPGEN   3392
#define XCD_BAR_WORDS 3456
#define XB_SPIN_CAP (1u << 22)
__device__ __forceinline__ unsigned xb_ld(unsigned* p)              { return __hip_atomic_load(p, __ATOMIC_RELAXED, __HIP_MEMORY_SCOPE_AGENT); }
__device__ __forceinline__ unsigned xb_add(unsigned* p, unsigned v) { return __hip_atomic_fetch_add(p, v, __ATOMIC_RELAXED, __HIP_MEMORY_SCOPE_AGENT); }
__device__ __forceinline__ unsigned xb_xcc_id() { return (unsigned)__builtin_amdgcn_s_getreg((3 << 11) | 20) & 0xFu; }
#define XB_SPIN(cond, bar) do { unsigned _sp = 0; while (cond) { __builtin_amdgcn_s_sleep(1); \
    if ((++_sp & 255u) == 0u) { if (xb_ld(&(bar)[XB_TMO])) break; if (_sp > XB_SPIN_CAP) { atomicAdd(&(bar)[XB_TMO], 1u); break; } } } } while (0)
struct XcdBarrier { unsigned* bar; unsigned x; volatile LAS unsigned* st; };
__device__ __forceinline__ XcdBarrier xcd_barrier_post(unsigned* bar, volatile LAS unsigned* st) {
    XcdBarrier b; b.bar = bar; b.x = xb_xcc_id(); b.st = st;
    if (threadIdx.x == 0) (void)xb_add(&bar[XB_XCNT(b.x)], 1u);
    return b;
}
__device__ __forceinline__ void xcd_barrier_complete(unsigned* bar, unsigned x, unsigned& nloc, unsigned& nx) {
    const unsigned G = gridDim.x * gridDim.y * gridDim.z;
    unsigned sum, cnt, mine, sp = 0u;
    for (;;) {
        sum = 0u; cnt = 0u; mine = 0u;
#pragma unroll
        for (unsigned j = 0; j < 16; ++j) { const unsigned c = xb_ld(&bar[XB_XCNT(j)]); sum += c; cnt += (c > 0u) ? 1u : 0u; mine = (j == x) ? c : mine; }
        if (sum == G) break;
        __builtin_amdgcn_s_sleep(1);
        if ((++sp & 255u) == 0u) { if (xb_ld(&bar[XB_TMO])) break; if (sp > XB_SPIN_CAP) { atomicAdd(&bar[XB_TMO], 1u); break; } }
    }
    nloc = mine > 0u ? mine : 1u; nx = cnt > 0u ? cnt : 1u;
}
__device__ __forceinline__ void xcd_barrier(const XcdBarrier& b) {
    asm volatile("s_waitcnt vmcnt(0)" ::: "memory");
    __syncthreads();
    if (threadIdx.x == 0) {
        unsigned* bar = b.bar;
        __builtin_amdgcn_s_waitcnt(0);
        unsigned nloc = b.st[0], nx = b.st[1];
        if (nloc == 0u) { xcd_barrier_complete(bar, b.x, nloc, nx); b.st[0] = nloc; b.st[1] = nx; }
        const unsigned old = xb_add(&bar[XB_XSUB(b.x)], 1u);
        const unsigned gen = old / nloc;
        if (old + 1u == (gen + 1u) * nloc) {
            __builtin_amdgcn_fence(__ATOMIC_RELEASE, "agent");
            asm volatile("s_waitcnt vmcnt(0)" ::: "memory");
            const unsigned og = xb_add(&bar[XB_TOP], 1u);
            const unsigned tg = og / nx;
            if (og + 1u == (tg + 1u) * nx) xb_add(&bar[XB_TOPGEN], 1u);
            else XB_SPIN(xb_ld(&bar[XB_TOPGEN]) == tg, bar);
            __builtin_amdgcn_fence(__ATOMIC_ACQUIRE, "agent");
            xb_add(&bar[XB_XGEN(b.x)], 1u);
            asm volatile("s_waitcnt vmcnt(0)" ::: "memory");
        } else {
            XB_SPIN(xb_ld(&bar[XB_XGEN(b.x)]) == gen, bar);
            __builtin_amdgcn_fence(__ATOMIC_ACQUIRE, "agent");
            asm volatile("s_waitcnt vmcnt(0)" ::: "memory");
        }
    }
    __syncthreads();
}

constexpr int PH_PER_LAYER = 14, N_PHASES = 2 * PH_PER_LAYER + 1;

__global__ void __launch_bounds__(512, 2) fwd_kernel(Params p, int ph_lo, int ph_hi) {
    extern __shared__ __attribute__((aligned(16))) unsigned char lds_raw[];
    LAS unsigned char* lds = (LAS unsigned char*)lds_raw;
    volatile LAS unsigned* bst = (volatile LAS unsigned*)(lds + 151552);
    if (threadIdx.x < 4) bst[threadIdx.x] = 0u;
    __syncthreads();
    XcdBarrier xbar; xbar.bar = (unsigned*)p.ws; xbar.x = 0; xbar.st = bst;
    if (ph_hi - ph_lo > 1) xbar = xcd_barrier_post((unsigned*)p.ws, bst);
    for (int ph = ph_lo; ph < ph_hi; ++ph) {
        const int G = NBLK(), c = BID();
        unsigned char* ws = WSP(p); float* xo = OUTP(p);
        bf16_t* W = (bf16_t*)(ws + WS_W); bf16_t* H = (bf16_t*)(ws + WS_H); bf16_t* ACT = (bf16_t*)(ws + WS_R);
        if (ph == N_PHASES - 1) { rmsnorm_phase(xo, INP(p, 35), nullptr, xo); }
        else {
            const int l = ph / PH_PER_LAYER, k = ph % PH_PER_LAYER;
            const float* xin = (l == 0) ? INP(p, 0) : xo;
            switch (k) {
            case 0: if (PHON(0)) for (int rep = 0; rep < REPS(0); ++rep) { prep_phase(p, l, lds); rmsnorm_phase(xin, INP(p, 1) + (size_t)l * D_, H, nullptr); } break;
            case 1: if (PHON(1)) for (int rep = 0; rep < REPS(1); ++rep) { pg8::Gemm g{H, W + W_GU1, T_, 5632, D_, 0, 0}; pg8::OrderPlain S; S.init(T_, 5632, G, c); pg8::EpiAct E{ACT}; pg8::gemm_phase(lds, g, S, E); } break;
            case 2: if (PHON(2)) { pg8::Gemm g{ACT, W + W_D1, T_, D_, FF_, 0, 0}; pg8::OrderPlain S; S.init(T_, D_, G, c); pg8::EpiRes E{xin, xo, 0.5f}; pg8::gemm_phase(lds, g, S, E); } break;
            case 3: if (PHON(3)) rmsnorm_phase(xo, INP(p, 5) + (size_t)l * D_, H, nullptr); break;
            case 4: if (PHON(4)) for (int rep = 0; rep < REPS(4); ++rep) { { pg8::Gemm g{H, W + W_IN, T_, ZC, D_, 0, 0}; pg8::OrderPlain S; S.init(T_, ZC, G, c); pg8::EpiZ E{(bf16_t*)(ws + WS_R + R_ZG), (bf16_t*)(ws + WS_R + R_ZR)}; pg8::gemm_phase(lds, g, S, E); }
                      { pg8::Gemm g{W + W_FOLD, H, 1024, T_, D_, 0, 0}; pg8::EpiFT E{(bf16_t*)(ws + WS_R + R_FT)};
                        if (G == 256) { pg8::OrderFill S; S.init(1024, T_, G, c, 128, 1, 3); pg8::gemm_phase(lds, g, S, E); }
                        else { pg8::OrderPlain S; S.init(1024, T_, G, c); pg8::gemm_phase(lds, g, S, E); } } } break;
            case 5: if (PHON(5)) for (int rep = 0; rep < REPS(5); ++rep) { { pg8::Gemm g{(const bf16_t*)(ws + WS_DM), (const bf16_t*)(ws + WS_R + R_FT), 1024, 512, SEQ_, (size_t)1024 * SEQ_ * 2, (size_t)512 * SEQ_ * 2, 1}; pg8::OrderBatch S; S.init(1024, 512, 2 * NB_, G, c);
                        pg8::EpiFnet E{(bf16_t*)(ws + WS_H + 32 * MiB)}; pg8::gemm_phase(lds, g, S, E); }
                      fnet_nyquist_phase(p);
                      gla_chunk_phase(p, l, lds);
                      } break;
            case 6: if (PHON(6)) { gla_post_phase(p, l); fnet_combine_phase(p); for (int rep = 0; rep < REPS(6); ++rep) {
                rwkv_chunk_phase(p, l, lds);
            } } break;
            case 7: if (PHON(7)) { rwkv_post_phase(p, l, lds); rmsnorm_phase(xo, INP(p, 5) + (size_t)l * D_, H, nullptr); } break;
            case 8: if (PHON(8)) for (int rep = 0; rep < REPS(8); ++rep) { pg8::Gemm g{H, W + W_GATE, T_, 3072, D_, 0, 0}; pg8::OrderPlain S; S.init(T_, 3072, G, c); pg8::EpiGate E{(bf16_t*)(ws + WS_R + R_G)}; pg8::gemm_phase(lds, g, S, E); } break;
            case 9: if (PHON(9)) for (int rep = 0; rep < REPS(9); ++rep) { pg8::Gemm g{(const bf16_t*)(ws + WS_Y), W + W_PROJ, T_, D_, 512, Y_STRIDE, (size_t)1024 * 512 * 2}; pg8::OrderMerge S; S.init(T_, 2 * D_, G, c);
                      pg8::EpiMerge E{(const bf16_t*)(ws + WS_R + R_G), H}; pg8::gemm_phase<pg8::EpiMerge, pg8::OrderMerge, true>(lds, g, S, E); } break;
            case 10: if (PHON(10)) { pg8::Gemm g{H, W + W_OUT, T_, D_, D_, 0, 0}; pg8::OrderPlain S; S.init(T_, D_, G, c); pg8::EpiRes E{xo, xo, 1.0f}; pg8::gemm_phase(lds, g, S, E); } break;
            case 11: if (PHON(11)) rmsnorm_phase(xo, INP(p, 31) + (size_t)l * D_, H, nullptr); break;
            case 12: if (PHON(12)) { pg8::Gemm g{H, W + W_GU2, T_, 5632, D_, 0, 0}; pg8::OrderPlain S; S.init(T_, 5632, G, c); pg8::EpiAct E{ACT}; pg8::gemm_phase(lds, g, S, E); } break;
            case 13: if (PHON(13)) { pg8::Gemm g{ACT, W + W_D2, T_, D_, FF_, 0, 0}; pg8::OrderPlain S; S.init(T_, D_, G, c); pg8::EpiRes E{xo, xo, 0.5f}; pg8::gemm_phase(lds, g, S, E); } break;
            }
        }
        if (ph + 1 < ph_hi) {
            if (ph == ph_lo) { __threadfence(); cg::this_grid().sync(); }
            else xcd_barrier(xbar);
        }
    }
}

constexpr int LDS_BYTES = 151552 + 16;

extern "C" void kernel_launch(void* const* d_in, const int* in_sizes, int n_in, void* d_out, int out_size, void* d_ws, size_t ws_size, hipStream_t stream) {
    static int grid = 0;
    if (grid == 0) {
        if (n_in != 36 || out_size != T_ * D_ || ws_size < WS_END) { fprintf(stderr, "kernel_launch: unexpected problem (n_in %d out %d ws %zu)\n", n_in, out_size, ws_size); grid = -1; return; }
        int dev = 0, cus = 0, per_cu = 0;
        hipGetDevice(&dev); hipDeviceGetAttribute(&cus, hipDeviceAttributeMultiprocessorCount, dev);
        if (hipFuncSetAttribute((const void*)fwd_kernel, hipFuncAttributeMaxDynamicSharedMemorySize, LDS_BYTES) != hipSuccess) { fprintf(stderr, "kernel_launch: hipFuncSetAttribute failed\n"); grid = -1; return; }
        hipOccupancyMaxActiveBlocksPerMultiprocessor(&per_cu, (const void*)fwd_kernel, 512, LDS_BYTES);
        (void)hipGetLastError();
        if (per_cu < 1) per_cu = 1;
        grid = cus * 1;
        fprintf(stderr, "kernel_launch: cus %d per_cu %d grid %d ws %zu\n", cus, per_cu, grid, ws_size);
    }
    if (grid < 0) return;
    Params p{};
    for (int i = 0; i < 36; ++i) p.in[i] = (const float*)d_in[i];
    p.out = (float*)d_out; p.ws = (unsigned char*)d_ws;
#if ONE_LAUNCH
    (void)hipMemsetAsync(d_ws, 0, XCD_BAR_WORDS * 4, stream);
    int lo = 0, hi = N_PHASES;
    void* args[] = {&p, &lo, &hi};
    hipError_t e = hipLaunchCooperativeKernel((const void*)fwd_kernel, dim3(grid), dim3(512), args, LDS_BYTES, stream);
    if (e != hipSuccess) fprintf(stderr, "cooperative launch failed: %s (grid %d)\n", hipGetErrorString(e), grid);
#else
    for (int ph = 0; ph < N_PHASES; ++ph) hipLaunchKernelGGL(fwd_kernel, dim3(grid), dim3(512), LDS_BYTES, stream, p, ph, ph + 1);
#endif
}
```

```cpp
#include <hip/hip_runtime.h>
#include <hip/hip_cooperative_groups.h>
#include <cstdio>
namespace cg = cooperative_groups;

#ifndef PHSEL
#define PHSEL -1
#endif
#define PHON(k) (PHSEL < 0 || PHSEL == (k))
#ifndef REP_K
#define REP_K -1
#endif
#ifndef REP_N
#define REP_N 1
#endif
#define REPS(k) (((k) == REP_K) ? REP_N : 1)
#ifndef STG_REP
#define STG_REP 1
#endif
#ifndef ONE_LAUNCH
#define ONE_LAUNCH 1
#endif

#define LAS __attribute__((address_space(3)))
typedef unsigned short bf16_t;
typedef short bf16x8 __attribute__((ext_vector_type(8)));
typedef float f32x4 __attribute__((ext_vector_type(4)));
typedef unsigned u32x4 __attribute__((ext_vector_type(4)));
typedef unsigned u32x2 __attribute__((ext_vector_type(2)));

constexpr int T_ = 32768, D_ = 1024, FF_ = 2816, SEQ_ = 2048, NB_ = 16;
constexpr int ZGC = 1568, ZRC = 1760, ZC = 3328, WINC = 6912;
constexpr size_t MiB = 1ull << 20;
constexpr size_t WS_BON = 1 * MiB, WS_W = 2 * MiB, WS_DM = 55 * MiB, WS_H = 71 * MiB, WS_R = 135 * MiB, WS_Y = 407 * MiB, WS_END = 503 * MiB;
constexpr size_t R_ZG = 0, R_ZR = 98 * MiB, R_FT = 208 * MiB, R_G = 0, R_SCR = 192 * MiB;
constexpr size_t Y_STRIDE = 32 * MiB;
constexpr size_t W_GU1 = 0, W_D1 = W_GU1 + 5632 * 1024, W_IN = W_D1 + 1024 * 2816, W_FOLD = W_IN + 3328 * 1024, W_GATE = W_FOLD + 1024 * 1024,
                 W_PROJ = W_GATE + 3072 * 1024, W_OUT = W_PROJ + 3 * 1024 * 512, W_GU2 = W_OUT + 1024 * 1024, W_D2 = W_GU2 + 5632 * 1024, W_TOTAL = W_D2 + 1024 * 2816;
static_assert(W_TOTAL * 2 <= 53 * MiB, "weights");

struct Params { const float* in[36]; float* out; unsigned char* ws; };
__device__ __forceinline__ const float* INP(const Params& p, int i) { asm volatile("" : "+s"(i)); return p.in[i]; }
__device__ __forceinline__ int TID() { int t = threadIdx.x; asm volatile("" : "+v"(t)); return t; }
__device__ __forceinline__ int BID() { int t = blockIdx.x; asm volatile("" : "+s"(t)); return t; }
__device__ __forceinline__ int NBLK() { int t = gridDim.x; asm volatile("" : "+s"(t)); return t; }
__device__ __forceinline__ unsigned char* WSP(const Params& p) { unsigned char* w = p.ws; asm volatile("" : "+s"(w)); return w; }
__device__ __forceinline__ float* OUTP(const Params& p) { float* w = p.out; asm volatile("" : "+s"(w)); return w; }


typedef float f32x2_t __attribute__((ext_vector_type(2)));
typedef __bf16 bf16x2_t __attribute__((ext_vector_type(2)));
__device__ __forceinline__ unsigned cvt_pk_bf16(float lo, float hi) { const f32x2_t v = {lo, hi}; const bf16x2_t b = __builtin_convertvector(v, bf16x2_t); return __builtin_bit_cast(unsigned, b); }
__device__ __forceinline__ float bf_lo(unsigned w) { return __uint_as_float(w << 16); }
__device__ __forceinline__ float bf_hi(unsigned w) { return __uint_as_float(w & 0xffff0000u); }
__device__ __forceinline__ float bf1(bf16_t b) { return __uint_as_float(((unsigned)b) << 16); }
__device__ __forceinline__ float sigmoid_(float x) { return __builtin_amdgcn_rcpf(1.0f + __expf(-x)); }
__device__ __forceinline__ float softplus_(float x) { return fmaxf(x, 0.f) + __logf(1.0f + __expf(-fabsf(x))); }
__device__ __forceinline__ float tanh_(float x) { const float t = __expf(-2.0f * fabsf(x)); const float r = (1.0f - t) * __builtin_amdgcn_rcpf(1.0f + t); return x < 0.f ? -r : r; }
__device__ __forceinline__ float dppf(float x, const int ctrl_sel) {
    const int xi = __float_as_int(x); int r;
    if (ctrl_sel == 0) r = __builtin_amdgcn_update_dpp(0, xi, 0xB1, 0xF, 0xF, true);
    else if (ctrl_sel == 1) r = __builtin_amdgcn_update_dpp(0, xi, 0x4E, 0xF, 0xF, true);
    else r = __builtin_amdgcn_update_dpp(0, xi, 0x141, 0xF, 0xF, true);
    return __int_as_float(r);
}
__device__ __forceinline__ float red8(float x) { x += dppf(x, 0); x += dppf(x, 1); x += dppf(x, 2); return x; }
__device__ __forceinline__ float red16d(float x) {
    x += dppf(x, 0); x += dppf(x, 1); x += dppf(x, 2); x += __int_as_float(__builtin_amdgcn_update_dpp(0, __float_as_int(x), 0x140, 0xF, 0xF, true)); return x; }
__device__ __forceinline__ float red16(float x) { x += __shfl_xor(x, 1); x += __shfl_xor(x, 2); x += __shfl_xor(x, 4); x += __shfl_xor(x, 8); return x; }
__device__ __forceinline__ void unpack8(const uint4 r, float (&f)[8]) {
    f[0] = bf_lo(r.x); f[1] = bf_hi(r.x); f[2] = bf_lo(r.y); f[3] = bf_hi(r.y); f[4] = bf_lo(r.z); f[5] = bf_hi(r.z); f[6] = bf_lo(r.w); f[7] = bf_hi(r.w);
}
__device__ __forceinline__ uint4 pack8(const float (&f)[8]) { uint4 r; r.x = cvt_pk_bf16(f[0], f[1]); r.y = cvt_pk_bf16(f[2], f[3]); r.z = cvt_pk_bf16(f[4], f[5]); r.w = cvt_pk_bf16(f[6], f[7]); return r; }

#define LBAR() do { asm volatile("s_waitcnt lgkmcnt(0)" ::: "memory"); __builtin_amdgcn_s_barrier(); asm volatile("" ::: "memory"); } while (0)

__device__ __forceinline__ void nt_store16(void* p, const uint4 v) { __builtin_nontemporal_store((u32x4){v.x, v.y, v.z, v.w}, (u32x4*)p); }

namespace pg8 {
constexpr int BM = 256, BK = 64, HALF = 128, HTB = HALF * BK * 2, STAGE_BYTES = 8 * HTB, NXCD = 8, WGM = 8;
__host__ __device__ __forceinline__ int lds_byte(int r, int c) { const int st = (r >> 4) * 2 + (c >> 5), rr = r & 15, cc = c & 31, ob = rr * 64 + cc * 2; return st * 1024 + (ob ^ (((ob >> 9) & 1) << 5)); }
__host__ __device__ __forceinline__ void stage_rc(int b, int& R, int& C) { const int st = b / 1024, sb = b % 1024, swz = sb ^ (((sb >> 9) & 1) << 5); R = (st >> 1) * 16 + swz / 64; C = (st & 1) * 32 + (swz % 64) / 2; }
__host__ __device__ __forceinline__ int perm32(int rho) { const int n = rho >> 4, i = rho & 15; return 8 * (i >> 2) + 4 * n + (i & 3); }

struct Unit { int pm, pn, z; };
struct Gemm { const bf16_t* A; const bf16_t* Bt; int M, N, K; size_t a_zs, b_zs; int a_zmask = -1; };

__device__ __forceinline__ void tile_map(int wgid, int nM, int nN, int nwg, int& pm, int& pn) {
    { const int q = nwg / NXCD, r = nwg % NXCD, xcd = wgid % NXCD, off = wgid / NXCD; wgid = (xcd < r ? xcd * (q + 1) : r * (q + 1) + (xcd - r) * q) + off; }
    const int nig = WGM * nN, gid = wgid / nig, fm = gid * WGM, gsz = (nM - fm) < WGM ? (nM - fm) : WGM;
    pm = fm + ((wgid % nig) % gsz); pn = (wgid % nig) / gsz;
}
struct OrderPlain {
    int nM, nN, nwg, G, c;
    __device__ void init(int M, int N, int G_, int c_) { nM = M / BM; nN = N / BM; nwg = nM * nN; G = G_; c = c_; }
    __device__ __forceinline__ bool next(int i, Unit& u) const { const long L = (long)i * G + c; if (L >= nwg) return false; tile_map((int)L, nM, nN, nwg, u.pm, u.pn); u.z = 0; return true; }
};
struct OrderFill {
    int nM, nN, nwg, G, c, nbig, lo, hi;
    __device__ void init(int M, int N, int G_, int c_, int nbig_, int lo_, int hi_) { nM = M / BM; nN = N / BM; nwg = nM * nN; G = G_; c = c_; nbig = nbig_; lo = lo_; hi = hi_; }
    __device__ __forceinline__ bool next(int i, Unit& u) const {
        int L;
        if (c < nbig) { if (i >= lo) return false; L = c * lo + i; } else { if (i >= hi) return false; L = nbig * lo + (c - nbig) * hi + i; }
        if (L >= nwg) return false;
        tile_map(L, nM, nN, nwg, u.pm, u.pn); u.z = 0; return true; }
};
struct OrderMerge {
    int nM, nN, nwg, G, c;
    __device__ void init(int M, int N, int G_, int c_) { nM = M / BM; nN = N / BM; nwg = nM * nN; G = G_; c = c_; }
    __device__ __forceinline__ bool next(int i, Unit& u) const { const long L = (long)(i / 3) * G + c; if (L >= nwg) return false; tile_map((int)L, nM, nN, nwg, u.pm, u.pn); u.z = i % 3; return true; }
};
struct OrderBatch {
    int nM, per, total, G, c;
    __device__ void init(int M, int N, int nb, int G_, int c_) { nM = M / BM; per = nM * (N / BM); total = per * nb; G = G_; c = c_; }
    __device__ __forceinline__ bool next(int i, Unit& u) const { const long L = (long)i * G + c; if (L >= total) return false; u.z = (int)(L / per); const int r = (int)(L % per); u.pm = r % nM; u.pn = r / nM; return true; }
};

template <class Epi, class Sched, bool HALFN = false>
__device__ __forceinline__ void gemm_phase(LAS unsigned char* lds, const Gemm g, const Sched& S, const Epi& E) {
    const int tid = TID(), wid = __builtin_amdgcn_readfirstlane(tid >> 6), lane = tid & 63, wr = wid >> 2, wc = wid & 3, fr = lane & 15, fq = lane >> 4;
    int K_ = g.K; asm volatile("" : "+s"(K_));
    const int K = K_, nt = K / BK;
    unsigned voffA[2], voffB[2];
#pragma unroll
    for (int i = 0; i < 2; ++i) { int R, C; stage_rc(tid * 16 + i * 8192, R, C); const int Rb = Epi::PERM ? ((R & ~31) + perm32(R & 31)) : R;
        voffA[i] = (unsigned)(R * K + C) * 2u; voffB[i] = (unsigned)(Rb * K + C) * 2u; }
    const size_t kstep = (size_t)(BK * 2);
    const size_t hstep = (size_t)HALF * K * 2;
    const size_t tstep = 2 * hstep;
    const size_t tstepB = HALFN ? hstep : tstep;
    const unsigned ldsw = (unsigned)wid * 1024u;
    const int aoff = lds_byte(wr * 64 + fr, fq * 8), boff = lds_byte(wc * 32 + fr, fq * 8);
#define PG8_SA(b, h) (((b) * 2 + (h)) * HTB)
#define PG8_SB(b, h) ((4 + (b) * 2 + (h)) * HTB)
#define PG8_STAGE(bufoff, gbase, voff) do { _Pragma("unroll") for (int _i = 0; _i < 2; ++_i) \
        __builtin_amdgcn_global_load_lds((const unsigned*)((const char*)(gbase) + (voff)[_i]), (LAS unsigned*)(lds + (bufoff) + ldsw + _i * 8192), 16, 0, 0); } while (0)
#define PG8_LDA(dst, b, h) do { _Pragma("unroll") for (int m = 0; m < 4; ++m) _Pragma("unroll") for (int k = 0; k < 2; ++k) dst[m][k] = *(const LAS bf16x8*)(lds + PG8_SA(b, h) + aoff + m * 2048 + k * 1024); } while (0)
#define PG8_LDB(dst, b, h) do { _Pragma("unroll") for (int n = 0; n < 2; ++n) _Pragma("unroll") for (int k = 0; k < 2; ++k) dst[n][k] = *(const LAS bf16x8*)(lds + PG8_SB(b, h) + boff + n * 2048 + k * 1024); } while (0)
#define PG8_MMA(ai, bj, At, Bt) do { __builtin_amdgcn_s_setprio(1); _Pragma("unroll") for (int m = 0; m < 4; ++m) _Pragma("unroll") for (int n = 0; n < 2; ++n) _Pragma("unroll") for (int k = 0; k < 2; ++k) \
        acc[ai][bj][m][n] = __builtin_amdgcn_mfma_f32_16x16x32_bf16(Bt[n][k], At[m][k], acc[ai][bj][m][n], 0, 0, 0); __builtin_amdgcn_s_setprio(0); } while (0)
#define PG8_WAIT_V(n) asm volatile("s_waitcnt vmcnt(" #n ")" ::: "memory")
#define PG8_WAIT_L(n) asm volatile("s_waitcnt lgkmcnt(" #n ")" ::: "memory")
#define PG8_BAR __builtin_amdgcn_s_barrier()
#define PG8_SCHED __builtin_amdgcn_sched_barrier(0)
    Unit cur, nxt; int ui = 0;
    if (!S.next(0, cur)) return;
    f32x4 acc[2][2][4][2];
#pragma unroll
    for (int a = 0; a < 2; ++a)
#pragma unroll
        for (int b = 0; b < 2; ++b)
#pragma unroll
            for (int m = 0; m < 4; ++m)
#pragma unroll
                for (int n = 0; n < 2; ++n) acc[a][b][m][n] = (f32x4){0.f, 0.f, 0.f, 0.f};
    bf16x8 At[4][2], B0[2][2], B1[2][2];
    const char* cA = (const char*)g.A + (size_t)(cur.z & g.a_zmask) * g.a_zs + (size_t)cur.pm * tstep; const char* cB = (const char*)g.Bt + (size_t)cur.z * g.b_zs + (size_t)cur.pn * tstepB;
    if constexpr (HALFN) {
        PG8_STAGE(PG8_SB(0, 0), cB, voffB); PG8_STAGE(PG8_SA(0, 0), cA, voffA); PG8_STAGE(PG8_SA(0, 1), cA + hstep, voffA);
        if (wr == 1) PG8_BAR;
        PG8_WAIT_V(2); PG8_BAR;
        PG8_STAGE(PG8_SB(1, 0), cB + kstep, voffB); PG8_STAGE(PG8_SA(1, 0), cA + kstep, voffA);
        PG8_WAIT_V(4); PG8_BAR;
    } else {
    PG8_STAGE(PG8_SB(0, 0), cB, voffB); PG8_STAGE(PG8_SB(0, 1), cB + hstep, voffB); PG8_STAGE(PG8_SA(0, 0), cA, voffA); PG8_STAGE(PG8_SA(0, 1), cA + hstep, voffA);
    if (wr == 1) PG8_BAR;
    PG8_WAIT_V(2); PG8_BAR;
    PG8_STAGE(PG8_SB(1, 0), cB + kstep, voffB); PG8_STAGE(PG8_SA(1, 0), cA + kstep, voffA); PG8_STAGE(PG8_SB(1, 1), cB + hstep + kstep, voffB);
    PG8_WAIT_V(6); PG8_BAR;
    }
    for (;;) {
        const bool has_next = S.next(ui + 1, nxt);
        const char* nA = has_next ? (const char*)g.A + (size_t)(nxt.z & g.a_zmask) * g.a_zs + (size_t)nxt.pm * tstep : cA; const char* nB = has_next ? (const char*)g.Bt + (size_t)nxt.z * g.b_zs + (size_t)nxt.pn * tstepB : cB;
#pragma unroll 1
        for (int t = 0; t < nt; t += 2) {
            const bool last = (t == nt - 2);
            const char* a1 = cA + (size_t)(t + 1) * kstep;
            const char* a2 = last ? nA : cA + (size_t)(t + 2) * kstep; const char* b2 = last ? nB : cB + (size_t)(t + 2) * kstep;
            const char* a3 = a2 + kstep; const char* b3 = b2 + kstep;
            if constexpr (HALFN) {
            PG8_LDB(B0, 0, 0); PG8_SCHED; PG8_LDA(At, 0, 0); PG8_STAGE(PG8_SA(1, 1), a1 + hstep, voffA);
            PG8_WAIT_V(6); PG8_WAIT_L(0); PG8_BAR; PG8_MMA(0, 0, At, B0); PG8_BAR; PG8_SCHED;
            PG8_LDA(At, 0, 1); PG8_STAGE(PG8_SB(0, 0), b2, voffB); PG8_STAGE(PG8_SA(0, 0), a2, voffA);
            PG8_WAIT_V(6); PG8_WAIT_L(0); PG8_BAR; PG8_MMA(1, 0, At, B0); PG8_BAR; PG8_SCHED;
            PG8_LDB(B0, 1, 0); PG8_SCHED; PG8_LDA(At, 1, 0); PG8_STAGE(PG8_SA(0, 1), a2 + hstep, voffA);
            PG8_WAIT_V(6); PG8_WAIT_L(0); PG8_BAR; PG8_MMA(0, 0, At, B0); PG8_BAR; PG8_SCHED;
            PG8_LDA(At, 1, 1); PG8_STAGE(PG8_SB(1, 0), b3, voffB); PG8_STAGE(PG8_SA(1, 0), a3, voffA);
            PG8_WAIT_V(6); PG8_WAIT_L(0); PG8_BAR; PG8_MMA(1, 0, At, B0); PG8_BAR; PG8_SCHED;
            } else {
            PG8_LDB(B0, 0, 0); PG8_LDB(B1, 0, 1); PG8_SCHED; PG8_LDA(At, 0, 0); PG8_STAGE(PG8_SA(1, 1), a1 + hstep, voffA);
            PG8_WAIT_V(8); PG8_WAIT_L(0); PG8_BAR; PG8_MMA(0, 0, At, B0); PG8_MMA(0, 1, At, B1); PG8_BAR; PG8_SCHED;
            PG8_LDA(At, 0, 1); PG8_STAGE(PG8_SB(0, 0), b2, voffB); PG8_STAGE(PG8_SB(0, 1), b2 + hstep, voffB); PG8_STAGE(PG8_SA(0, 0), a2, voffA);
            PG8_WAIT_V(8); PG8_WAIT_L(0); PG8_BAR; PG8_MMA(1, 0, At, B0); PG8_MMA(1, 1, At, B1); PG8_BAR; PG8_SCHED;
            PG8_LDB(B0, 1, 0); PG8_LDB(B1, 1, 1); PG8_SCHED; PG8_LDA(At, 1, 0); PG8_STAGE(PG8_SA(0, 1), a2 + hstep, voffA);
            PG8_WAIT_V(8); PG8_WAIT_L(0); PG8_BAR; PG8_MMA(0, 0, At, B0); PG8_MMA(0, 1, At, B1); PG8_BAR; PG8_SCHED;
            PG8_LDA(At, 1, 1); PG8_STAGE(PG8_SB(1, 0), b3, voffB); PG8_STAGE(PG8_SB(1, 1), b3 + hstep, voffB); PG8_STAGE(PG8_SA(1, 0), a3, voffA);
            PG8_WAIT_V(8); PG8_WAIT_L(0); PG8_BAR; PG8_MMA(1, 0, At, B0); PG8_MMA(1, 1, At, B1); PG8_BAR; PG8_SCHED;
            }
        }
        if (wr == 0) PG8_BAR;
        E(acc, cur, wr, wc, fr, fq);
        if (!has_next) break;
#pragma unroll
        for (int a = 0; a < 2; ++a)
#pragma unroll
            for (int b = 0; b < (HALFN ? 1 : 2); ++b)
#pragma unroll
                for (int m = 0; m < 4; ++m)
#pragma unroll
                    for (int n = 0; n < 2; ++n) acc[a][b][m][n] = (f32x4){0.f, 0.f, 0.f, 0.f};
        cur = nxt; cA = nA; cB = nB; ++ui;
        if (wr == 1) PG8_BAR;
    }
    PG8_WAIT_V(0);
    PG8_BAR;
#undef PG8_SA
#undef PG8_SB
#undef PG8_STAGE
#undef PG8_LDA
#undef PG8_LDB
#undef PG8_MMA
#undef PG8_WAIT_V
#undef PG8_WAIT_L
#undef PG8_BAR
#undef PG8_SCHED
}

typedef const f32x4 (&AccT)[2][2][4][2];
typedef f32x4 (&AccM)[2][2][4][2];

struct EpiAct {
    static constexpr bool PERM = true;
    bf16_t* O;
    __device__ __forceinline__ void operator()(AccT acc, const Unit& u, int wr, int wc, int fr, int fq) const {
        const int row0 = u.pm * BM + wr * 64 + fr, col0 = u.pn * 128 + wc * 32 + 8 * fq;
#pragma unroll
        for (int ai = 0; ai < 2; ++ai)
#pragma unroll
            for (int m = 0; m < 4; ++m) {
                bf16_t* rowp = O + (size_t)(row0 + ai * HALF + m * 16) * FF_ + col0;
                float o[8];
#pragma unroll
                for (int n = 0; n < 2; ++n)
#pragma unroll
                    for (int j = 0; j < 4; ++j) { const float gt = acc[ai][0][m][n][j], up = acc[ai][1][m][n][j]; o[n * 4 + j] = gt * sigmoid_(gt) * up; }
                nt_store16(rowp, pack8(o));
            }
    }
};
struct EpiRes {
    static constexpr bool PERM = false;
    const float* xin; float* xout; float scale;
    __device__ __forceinline__ void operator()(AccT acc, const Unit& u, int wr, int wc, int fr, int fq) const {
        const int row0 = u.pm * BM + wr * 64 + fr, col0 = u.pn * BM + wc * 32 + 4 * fq;
#pragma unroll
        for (int ai = 0; ai < 2; ++ai)
#pragma unroll
            for (int m = 0; m < 4; ++m) { const size_t off = (size_t)(row0 + ai * HALF + m * 16) * D_ + col0;
#pragma unroll
                for (int bj = 0; bj < 2; ++bj)
#pragma unroll
                    for (int n = 0; n < 2; ++n) { const f32x4 bs = *(const f32x4*)(xin + off + bj * HALF + n * 16); *(f32x4*)(xout + off + bj * HALF + n * 16) = bs + acc[ai][bj][m][n] * scale; }
                asm volatile("" ::: "memory"); }
    }
};
__device__ __forceinline__ uint4 pack_acc8(const f32x4 a, const f32x4 b, float s) { uint4 w; w.x = cvt_pk_bf16(a[0] * s, a[1] * s); w.y = cvt_pk_bf16(a[2] * s, a[3] * s); w.z = cvt_pk_bf16(b[0] * s, b[1] * s); w.w = cvt_pk_bf16(b[2] * s, b[3] * s); return w; }
struct EpiZ {
    static constexpr bool PERM = true;
    bf16_t* ZG; bf16_t* ZR;
    __device__ __forceinline__ void operator()(AccT acc, const Unit& u, int wr, int wc, int fr, int fq) const {
        const int row0 = u.pm * BM + wr * 64 + fr, col0 = u.pn * BM + wc * 32 + 8 * fq;
#pragma unroll
        for (int ai = 0; ai < 2; ++ai)
#pragma unroll
            for (int m = 0; m < 4; ++m) { const size_t row = (size_t)(row0 + ai * HALF + m * 16);
#pragma unroll
                for (int bj = 0; bj < 2; ++bj) { const int c = col0 + bj * HALF;
                    bf16_t* dst = (c < ZGC) ? (ZG + row * ZGC + c) : (ZR + row * ZRC + (c - ZGC));
                    nt_store16(dst, pack_acc8(acc[ai][bj][m][0], acc[ai][bj][m][1], 1.0f)); } }
    }
};
struct EpiFT {
    static constexpr bool PERM = true;
    bf16_t* FT;
    __device__ __forceinline__ void operator()(AccT acc, const Unit& u, int wr, int wc, int fr, int fq) const {
        const int row0 = u.pm * BM + wr * 64 + fr, col0 = u.pn * BM + wc * 32 + 8 * fq;
#pragma unroll
        for (int ai = 0; ai < 2; ++ai)
#pragma unroll
            for (int m = 0; m < 4; ++m) { const int row = row0 + ai * HALF + m * 16;
#pragma unroll
                for (int bj = 0; bj < 2; ++bj) { const int c = col0 + bj * HALF; const int b = c >> 11, s = c & 2047;
                    *(uint4*)(FT + ((size_t)((b * 2 + (row & 1)) * 512 + (row >> 1)) * SEQ_ + s)) = pack_acc8(acc[ai][bj][m][0], acc[ai][bj][m][1], 1.0f); } }
    }
};
struct EpiFnet {
    static constexpr bool PERM = true;
    bf16_t* PQ;
    __device__ __forceinline__ void operator()(AccT acc, const Unit& u, int wr, int wc, int fr, int fq) const {
        const int row0 = u.pm * BM + wr * 64 + fr, col0 = u.pn * BM + wc * 32 + 8 * fq;
#pragma unroll
        for (int ai = 0; ai < 2; ++ai)
#pragma unroll
            for (int m = 0; m < 4; ++m) { const size_t row = (size_t)u.z * 1024 + (row0 + ai * HALF + m * 16);
#pragma unroll
                for (int bj = 0; bj < 2; ++bj) *(uint4*)(PQ + row * 512 + col0 + bj * HALF) = pack_acc8(acc[ai][bj][m][0], acc[ai][bj][m][1], 1.0f / 512.0f); }
    }
};
struct EpiGate {
    static constexpr bool PERM = true;
    bf16_t* G;
    __device__ __forceinline__ void operator()(AccT acc, const Unit& u, int wr, int wc, int fr, int fq) const {
        const int row0 = u.pm * BM + wr * 64 + fr, col0 = u.pn * BM + wc * 32 + 8 * fq;
#pragma unroll
        for (int ai = 0; ai < 2; ++ai)
#pragma unroll
            for (int m = 0; m < 4; ++m) { const size_t row = (size_t)(row0 + ai * HALF + m * 16);
#pragma unroll
                for (int bj = 0; bj < 2; ++bj) { float o[8];
#pragma unroll
                    for (int n = 0; n < 2; ++n)
#pragma unroll
                        for (int j = 0; j < 4; ++j) o[n * 4 + j] = sigmoid_(acc[ai][bj][m][n][j]);
                    nt_store16(G + row * 3072 + col0 + bj * HALF, pack8(o)); } }
    }
};
struct EpiMerge {
    static constexpr bool PERM = true;
    const bf16_t* G; bf16_t* MB;
    __device__ __forceinline__ void operator()(AccM acc, const Unit& u, int wr, int wc, int fr, int fq) const {
        const int row0 = u.pm * BM + wr * 64 + fr, col0 = u.pn * HALF + wc * 32 + 8 * fq;
        const bf16_t* gb = G + (size_t)row0 * 3072 + u.z * 1024 + col0;
        bf16_t* mb = MB + (size_t)row0 * D_ + col0;
        const int z = u.z;
#pragma unroll
        for (int ai = 0; ai < 2; ++ai)
#pragma unroll
            for (int m = 0; m < 4; ++m) {
                const u32x4 gr_ = __builtin_nontemporal_load((const u32x4*)(gb + (size_t)(ai * HALF + m * 16) * 3072)); const uint4 gr = make_uint4(gr_[0], gr_[1], gr_[2], gr_[3]); float gf[8]; unpack8(gr, gf);
                f32x4 v0, v1;
#pragma unroll
                for (int j = 0; j < 4; ++j) { v0[j] = gf[j] * acc[ai][0][m][0][j]; v1[j] = gf[4 + j] * acc[ai][0][m][1][j]; }
                if (z > 0) { v0 += acc[ai][1][m][0]; v1 += acc[ai][1][m][1]; }
                acc[ai][1][m][0] = v0; acc[ai][1][m][1] = v1;
                if (z == 2) *(uint4*)(mb + (size_t)(ai * HALF + m * 16) * D_) = pack_acc8(v0, v1, 1.0f);
                asm volatile("" ::: "memory");
            }
    }
};
}

__device__ __forceinline__ void tr_cvt(const float* __restrict__ src, const float* __restrict__ src2, int srcsel, int ld, int K, int N, bf16_t* __restrict__ dst, LAS float* tl) {
    const int tid = TID(), nkt = K / 64, nnt = N / 64, ntiles = nkt * nnt;
    const int lr = tid >> 4, lc = (tid & 15) * 4;
    const int wn = tid >> 3, wk = (tid & 7) * 8;
    float4 va[2], vb[2]; va[0] = va[1] = vb[0] = vb[1] = make_float4(0.f, 0.f, 0.f, 0.f);
#define TRC_LOAD(tt, q) do { const int kt_ = (tt) % nkt, nn_ = (tt) / nkt; const int n0_ = nn_ * 64, k0_ = kt_ * 64; const float* sp_; int c0_; \
        if (srcsel == 0) { sp_ = src; c0_ = n0_; } else { const int w_ = n0_ & 255; sp_ = (w_ < 128) ? src : src2; c0_ = (n0_ >> 8) * 128 + (w_ & 127); } \
        va[q] = *(const float4*)(sp_ + (size_t)(k0_ + lr) * ld + c0_ + lc); vb[q] = *(const float4*)(sp_ + (size_t)(k0_ + lr + 32) * ld + c0_ + lc); } while (0)
    const int G2 = 2 * NBLK();
    int t = BID();
    if (t < ntiles) TRC_LOAD(t, 0);
    if (t + NBLK() < ntiles) TRC_LOAD(t + NBLK(), 1);
    for (; t < ntiles; t += G2) {
        const bool has2 = t + NBLK() < ntiles;
        LBAR();
#pragma unroll
        for (int q = 0; q < 2; ++q) if (q == 0 || has2) {
            float4 x0 = va[q], x1 = vb[q];
            LAS float* r0 = tl + q * 4160 + lr * 65 + lc; LAS float* r1 = tl + q * 4160 + (lr + 32) * 65 + lc;
            r0[0] = x0.x; r0[1] = x0.y; r0[2] = x0.z; r0[3] = x0.w; r1[0] = x1.x; r1[1] = x1.y; r1[2] = x1.z; r1[3] = x1.w; }
        if (t + G2 < ntiles) TRC_LOAD(t + G2, 0);
        if (t + G2 + NBLK() < ntiles) TRC_LOAD(t + G2 + NBLK(), 1);
        LBAR();
#pragma unroll
        for (int q = 0; q < 2; ++q) if (q == 0 || has2) {
            const int tt = t + q * NBLK(); const int n0 = (tt / nkt) * 64, k0 = (tt % nkt) * 64;
            float f[8];
#pragma unroll
            for (int j = 0; j < 8; ++j) f[j] = tl[q * 4160 + (wk + j) * 65 + wn];
            *(uint4*)(dst + (size_t)(n0 + wn) * K + k0 + wk) = pack8(f); }
    }
#undef TRC_LOAD
}
__device__ void prep_phase(const Params& p, int l, LAS unsigned char* lds) {
    const int tid = TID(), gtid = BID() * 512 + tid, gsz = NBLK() * 512;
    bf16_t* W = (bf16_t*)(WSP(p) + WS_W);
    LAS float* cosT = (LAS float*)lds; LAS float* sinT = cosT + 128;
    if (tid < 128) { cosT[tid] = cospif((float)tid * (1.0f / 64.0f)); sinT[tid] = sinpif((float)tid * (1.0f / 64.0f)); }
    __syncthreads();
    const float* w_in = INP(p, 6) + (size_t)l * D_ * WINC;
    LAS float* tl = (LAS float*)(lds + 4096);
    tr_cvt(INP(p, 2) + (size_t)l * D_ * FF_, INP(p, 3) + (size_t)l * D_ * FF_, 1, FF_, D_, 5632, W + W_GU1, tl);
    tr_cvt(INP(p, 4) + (size_t)l * FF_ * D_, nullptr, 0, D_, FF_, D_, W + W_D1, tl);
    tr_cvt(w_in, nullptr, 0, WINC, D_, 1536, W + W_IN, tl);
    tr_cvt(w_in + 2080, nullptr, 0, WINC, D_, ZRC - 32, W + W_IN + (size_t)ZGC * D_, tl);
    tr_cvt(w_in + 3840, nullptr, 0, WINC, D_, 3072, W + W_GATE, tl);
    tr_cvt(INP(p, 27) + (size_t)l * 512 * D_, nullptr, 0, D_, 512, D_, W + W_PROJ, tl);
    tr_cvt(INP(p, 28) + (size_t)l * 512 * D_, nullptr, 0, D_, 512, D_, W + W_PROJ + 1024 * 512, tl);
    tr_cvt(INP(p, 29) + (size_t)l * 512 * D_, nullptr, 0, D_, 512, D_, W + W_PROJ + 2 * 1024 * 512, tl);
    tr_cvt(INP(p, 30) + (size_t)l * D_ * D_, nullptr, 0, D_, D_, D_, W + W_OUT, tl);
    tr_cvt(INP(p, 32) + (size_t)l * D_ * FF_, INP(p, 33) + (size_t)l * D_ * FF_, 1, FF_, D_, 5632, W + W_GU2, tl);
    tr_cvt(INP(p, 34) + (size_t)l * FF_ * D_, nullptr, 0, D_, FF_, D_, W + W_D2, tl);
    for (int i = gtid; i < 64 * (D_ / 8); i += gsz) {
        const int n = i & 63, kc = i >> 6; const int srccol = (n < 32) ? (1536 + n) : (2080 + 1728 + (n - 32)); const int drow = (n < 32) ? (1536 + n) : (ZGC + 1728 + (n - 32));
        float v[8];
#pragma unroll
        for (int j = 0; j < 8; ++j) v[j] = w_in[(size_t)(kc * 8 + j) * WINC + srccol];
        *(uint4*)(W + W_IN + (size_t)drow * D_ + kc * 8) = pack8(v);
    }
    {   LAS float* ws_ = (LAS float*)(lds + 2048);
        const int q = tid >> 7, cp = tid & 127;
        for (int pr = BID() * 4; pr < 4096; pr += NBLK() * 4) {
            const int pair = pr + q, k = pair >> 2, g = pair & 3;
            __syncthreads();
            ws_[tid] = w_in[(size_t)k * WINC + 1568 + g * 128 + cp];
            __syncthreads();
            float ca = 0.f, sa = 0.f;
#pragma unroll 8
            for (int c = 0; c < 128; ++c) { const float w = ws_[q * 128 + c]; const int j = (c * cp) & 127; ca += w * cosT[j]; sa += w * sinT[j]; }
            const size_t n0 = (size_t)(g * 128 + cp) * 2;
            W[W_FOLD + n0 * 1024 + k] = (bf16_t)(cvt_pk_bf16(ca, ca) & 0xffffu); W[W_FOLD + (n0 + 1) * 1024 + k] = (bf16_t)(cvt_pk_bf16(sa, sa) & 0xffffu);
        }
    }
    if (l == 0) {
        unsigned* DM = (unsigned*)(WSP(p) + WS_DM);
        for (int i = gtid; i < 2 * 1024 * 1024; i += gsz) {
            const int part = i >> 20, sp = (i >> 10) & 1023, s0 = (i & 1023) * 2;
            const int j0 = (sp * s0) & 2047, j1 = (sp * (s0 + 1)) & 2047;
            float v0, v1;
            if (part) { v0 = sinpif((float)j0 * (1.0f / 1024.0f)); v1 = sinpif((float)j1 * (1.0f / 1024.0f)); }
            else { v0 = cospif((float)j0 * (1.0f / 1024.0f)); v1 = cospif((float)j1 * (1.0f / 1024.0f)); }
            DM[i] = cvt_pk_bf16(v0, v1);
        }
    }
}

__device__ void fnet_nyquist_phase(const Params& p) {
    const int lane = TID() & 63, gw = BID() * 8 + (TID() >> 6), nw = NBLK() * 8;
    const bf16_t* FT = (const bf16_t*)(WSP(p) + WS_R + R_FT); bf16_t* YB = (bf16_t*)(WSP(p) + WS_Y + Y_STRIDE);
    for (int pr = gw; pr < NB_ * 512; pr += nw) {
        const int b = pr >> 9, n = pr & 511;
        const bf16_t* a = FT + ((size_t)(b * 2) * 512 + n) * SEQ_;
        float acc = 0.f;
#pragma unroll
        for (int i = 0; i < 4; ++i) { float f[8]; unpack8(*(const uint4*)(a + (lane + 64 * i) * 8), f); acc += (f[0] - f[1]) + (f[2] - f[3]) + (f[4] - f[5]) + (f[6] - f[7]); }
#pragma unroll
        for (int o = 32; o >= 1; o >>= 1) acc += __shfl_xor(acc, o);
        if (lane == 0) { const float y = acc * (1.0f / 512.0f); YB[((size_t)b * SEQ_ + 1024) * 512 + n] = (bf16_t)(cvt_pk_bf16(y, y) & 0xffffu); }
    }
}
__device__ void fnet_combine_phase(const Params& p) {
    const int gtid = BID() * 512 + TID(), gsz = NBLK() * 512;
    const bf16_t* PQ = (const bf16_t*)(WSP(p) + WS_H + 32 * MiB); bf16_t* YB = (bf16_t*)(WSP(p) + WS_Y + Y_STRIDE);
    for (int idx = gtid; idx < NB_ * 1024 * 64; idx += gsz) {
        const int n8 = (idx & 63) * 8, sp = (idx >> 6) & 1023, b = idx >> 16;
        float pf[8], qf[8], d[8], sm[8];
        unpack8(*(const uint4*)(PQ + ((size_t)(b * 2) * 1024 + sp) * 512 + n8), pf); unpack8(*(const uint4*)(PQ + ((size_t)(b * 2 + 1) * 1024 + sp) * 512 + n8), qf);
#pragma unroll
        for (int j = 0; j < 8; ++j) { d[j] = pf[j] - qf[j]; sm[j] = pf[j] + qf[j]; }
        *(uint4*)(YB + ((size_t)b * SEQ_ + sp) * 512 + n8) = pack8(d);
        if (sp > 0) *(uint4*)(YB + ((size_t)b * SEQ_ + (SEQ_ - sp)) * 512 + n8) = pack8(sm);
    }
}

__device__ void rmsnorm_phase(const float* __restrict__ x, const float* __restrict__ g, bf16_t* h, float* outf) {
    const int lane = TID() & 63, gw = BID() * 8 + (TID() >> 6), nw = NBLK() * 8;
    float4 gv[4];
#pragma unroll
    for (int i = 0; i < 4; ++i) gv[i] = ((const float4*)g)[lane + 64 * i];
    for (int row = gw; row < T_; row += nw) {
        const float4* xr = (const float4*)(x + (size_t)row * D_);
        float4 v[4]; float ss = 0.f;
#pragma unroll
        for (int i = 0; i < 4; ++i) { v[i] = xr[lane + 64 * i]; ss += v[i].x * v[i].x + v[i].y * v[i].y + v[i].z * v[i].z + v[i].w * v[i].w; }
#pragma unroll
        for (int o = 32; o >= 1; o >>= 1) ss += __shfl_xor(ss, o);
        const float rs = rsqrtf(ss * (1.0f / 1024.0f) + 1e-6f);
#pragma unroll
        for (int i = 0; i < 4; ++i) {
            const float a = v[i].x * rs * gv[i].x, b = v[i].y * rs * gv[i].y, c = v[i].z * rs * gv[i].z, d = v[i].w * rs * gv[i].w;
            if (outf) ((float4*)(outf + (size_t)row * D_))[lane + 64 * i] = make_float4(a, b, c, d);
            else { u32x2 w; w.x = cvt_pk_bf16(a, b); w.y = cvt_pk_bf16(c, d); *(u32x2*)(h + (size_t)row * D_ + (lane + 64 * i) * 4) = w; }
        }
    }
}


struct GlaOps { f32x4 a0, a1, k0, k1, q0, q1; float vv; };
__device__ __forceinline__ GlaOps gla_load(const LAS float* q_s, int s, int v, int ko) {
    GlaOps o; const LAS float* b = q_s + s * 64 + ko * 8;
    o.q0 = *(const LAS f32x4*)(b); o.q1 = *(const LAS f32x4*)(b + 4);
    o.k0 = *(const LAS f32x4*)(b + 4096); o.k1 = *(const LAS f32x4*)(b + 4100);
    o.a0 = *(const LAS f32x4*)(b + 8192); o.a1 = *(const LAS f32x4*)(b + 8196);
    o.vv = q_s[12288 + s * 64 + v]; return o;
}
template <int DIR> __device__ __forceinline__ void gla_step(float (&S)[8], const GlaOps& p, LAS float* o_s, int s, int v, int ko) {
    float o = 0.f;
    if (DIR) {
#pragma unroll
        for (int j = 0; j < 4; ++j) { S[j] *= p.a0[j]; S[4 + j] *= p.a1[j]; o += p.q0[j] * S[j] + p.q1[j] * S[4 + j]; S[j] += p.k0[j] * p.vv; S[4 + j] += p.k1[j] * p.vv; }
    } else {
#pragma unroll
        for (int j = 0; j < 4; ++j) { S[j] = S[j] * p.a0[j] + p.k0[j] * p.vv; S[4 + j] = S[4 + j] * p.a1[j] + p.k1[j] * p.vv; o += p.q0[j] * S[j] + p.q1[j] * S[4 + j]; }
    }
    o = red8(o);
    if (ko == 0) o_s[s * 64 + v] = o;
}
template <int DIR> __device__ __forceinline__ void gla_steps(float (&S)[8], LAS float* q_s, int v, int ko) {
    LAS float* o_s = q_s + 16384;
    GlaOps a = gla_load(q_s, DIR ? 63 : 0, v, ko);
#pragma unroll 1
    for (int si = 0; si < 64; si += 2) {
        const int s0 = DIR ? 63 - si : si, s1 = DIR ? 62 - si : si + 1, s2 = DIR ? (si < 62 ? 61 - si : 0) : (si < 62 ? si + 2 : 63);
        const GlaOps b = gla_load(q_s, s1, v, ko);
        gla_step<DIR>(S, a, o_s, s0, v, ko);
        a = gla_load(q_s, s2, v, ko);
        gla_step<DIR>(S, b, o_s, s1, v, ko);
    }
}

__device__ void gla_scan_phase(const Params& p, int l, LAS unsigned char* lds) {
    const int tid = TID();
    const bf16_t* ZG = (const bf16_t*)(WSP(p) + WS_R + R_ZG);
    LAS float* q_s = (LAS float*)lds; LAS float* k_s = q_s + 4096; LAS float* a_s = k_s + 4096; LAS float* v_s = a_s + 4096; LAS float* o_s = v_s + 4096;
    LAS float* up_s = o_s + 4096; LAS float* dn_s = up_s + 1024; LAS float* bias_s = dn_s + 1024;
    for (int w = BID(); w < 256; w += NBLK()) {
        const int vh = w & 1, dir = (w >> 1) & 1, h = (w >> 2) & 3, b = w >> 4;
        const float* up = (dir ? INP(p, 9) : INP(p, 7)) + (size_t)l * 16 * 256; const float* bias = (dir ? INP(p, 10) : INP(p, 8)) + (size_t)l * 256;
        bf16_t* O = dir ? (bf16_t*)(WSP(p) + WS_H) : (bf16_t*)(WSP(p) + WS_Y);
        __syncthreads();
        for (int i = tid; i < 1024; i += 512) up_s[i] = up[(i >> 6) * 256 + h * 64 + (i & 63)];
        if (tid < 64) bias_s[tid] = bias[h * 64 + tid];
        float S[8];
#pragma unroll
        for (int j = 0; j < 8; ++j) S[j] = 0.f;
        const int v = tid >> 3, ko = tid & 7;
        const int ltok = tid >> 3, lc8 = (tid & 7) * 8;
        const int dtok = (tid & 127) >> 1, dc8 = (tid & 1) * 8;
        const int dncol = dir ? 1552 : 1536;
        uint4 rq, rk, rv, rd; rd = make_uint4(0, 0, 0, 0);
        {   const int c = dir ? 31 : 0; const size_t tb = (size_t)b * SEQ_ + c * 64;
            const bf16_t* zr = ZG + (tb + ltok) * ZGC;
            rq = *(const uint4*)(zr + h * 64 + lc8); rk = *(const uint4*)(zr + 256 + h * 64 + lc8); rv = *(const uint4*)(zr + 512 + h * 128 + vh * 64 + lc8);
            if (tid < 128) rd = *(const uint4*)(ZG + (tb + dtok) * ZGC + dncol + dc8); }
        for (int ci = 0; ci < 32; ++ci) {
            const int c = dir ? 31 - ci : ci; const size_t t0 = (size_t)b * SEQ_ + c * 64;
            __syncthreads();
            {   float f[8];
                unpack8(rq, f);
#pragma unroll
                for (int j = 0; j < 8; ++j) q_s[ltok * 64 + lc8 + j] = f[j] * 0.125f;
                unpack8(rk, f);
#pragma unroll
                for (int j = 0; j < 8; ++j) k_s[ltok * 64 + lc8 + j] = f[j];
                unpack8(rv, f);
#pragma unroll
                for (int j = 0; j < 8; ++j) v_s[ltok * 64 + lc8 + j] = f[j];
                if (tid < 128) { unpack8(rd, f);
#pragma unroll
                    for (int j = 0; j < 8; ++j) dn_s[dtok * 16 + dc8 + j] = f[j]; } }
            __syncthreads();
            {   float z[8];
#pragma unroll
                for (int j = 0; j < 8; ++j) z[j] = bias_s[lc8 + j];
#pragma unroll
                for (int i = 0; i < 16; ++i) { const float d = dn_s[ltok * 16 + i];
#pragma unroll
                    for (int j = 0; j < 8; ++j) z[j] += d * up_s[i * 64 + lc8 + j]; }
#pragma unroll
                for (int j = 0; j < 8; ++j) a_s[ltok * 64 + lc8 + j] = __expf(-softplus_(-z[j]) * (1.0f / 16.0f)); }
            if (ci + 1 < 32) {
                const int cn = dir ? 30 - ci : ci + 1; const size_t tb = (size_t)b * SEQ_ + cn * 64;
                const bf16_t* zr = ZG + (tb + ltok) * ZGC;
                rq = *(const uint4*)(zr + h * 64 + lc8); rk = *(const uint4*)(zr + 256 + h * 64 + lc8); rv = *(const uint4*)(zr + 512 + h * 128 + vh * 64 + lc8);
                if (tid < 128) rd = *(const uint4*)(ZG + (tb + dtok) * ZGC + dncol + dc8); }
            __syncthreads();
            if (dir) gla_steps<1>(S, q_s, v, ko); else gla_steps<0>(S, q_s, v, ko);
            __syncthreads();
            {   float f[8];
#pragma unroll
                for (int j = 0; j < 8; ++j) f[j] = o_s[ltok * 64 + lc8 + j];
                *(uint4*)(O + (t0 + ltok) * 512 + h * 128 + vh * 64 + lc8) = pack8(f); }
        }
    }
}

template <int KS> __device__ __forceinline__ f32x4 mm_nt(const LAS bf16_t* X, int ldx, int xr, const LAS bf16_t* Y, int ldy, int yr, int r16, int quad, f32x4 acc) {
#pragma unroll
    for (int ks = 0; ks < KS; ++ks) {
        const bf16x8 a = *(const LAS bf16x8*)(X + (xr + r16) * ldx + ks * 32 + quad * 8), b = *(const LAS bf16x8*)(Y + (yr + r16) * ldy + ks * 32 + quad * 8);
        acc = __builtin_amdgcn_mfma_f32_16x16x32_bf16(a, b, acc, 0, 0, 0); }
    return acc;
}
typedef short s4v __attribute__((ext_vector_type(4)));
__device__ __forceinline__ bf16x8 trfrag(const LAS bf16_t* M, int ld, int krow0, int col0, int lane) {
    const int quad = lane >> 4, q = (lane & 15) >> 2, pp = lane & 3;
    const LAS bf16_t* a = M + (krow0 + quad * 8 + q) * ld + col0 + 4 * pp;
    const s4v lo = __builtin_amdgcn_ds_read_tr16_b64_v4i16((LAS s4v*)a);
    const s4v hi = __builtin_amdgcn_ds_read_tr16_b64_v4i16((LAS s4v*)(a + 4 * ld));
    bf16x8 r; r[0] = lo[0]; r[1] = lo[1]; r[2] = lo[2]; r[3] = lo[3]; r[4] = hi[0]; r[5] = hi[1]; r[6] = hi[2]; r[7] = hi[3];
    return r;
}
__device__ __forceinline__ void st_bf(LAS bf16_t* p, float x) { *p = (bf16_t)(cvt_pk_bf16(x, x) & 0xffffu); }
__device__ __forceinline__ void st_bf4(LAS bf16_t* p, const f32x4 v) { u32x2 w; w.x = cvt_pk_bf16(v[0], v[1]); w.y = cvt_pk_bf16(v[2], v[3]); *(LAS u32x2*)p = w; }
__device__ __forceinline__ float ld_bf(const LAS bf16_t* p) { return bf1(*p); }

__device__ void gla_chunk_phase(const Params& p, int l, LAS unsigned char* lds) {
    const int tid = TID(), lane = tid & 63, wid = tid >> 6;
    const bf16_t* ZG = (const bf16_t*)(WSP(p) + WS_R + R_ZG);
    LAS float* b_s = (LAS float*)lds;
    LAS bf16_t* qd = (LAS bf16_t*)(lds + 16384); LAS bf16_t* kd = qd + 4608; LAS bf16_t* ktT = kd + 4608; LAS bf16_t* vT = ktT + 4608; LAS bf16_t* Pm = vT + 4608; LAS bf16_t* stT = Pm + 4608;
    LAS float* o_s = (LAS float*)(lds + 71680);
    LAS bf16_t* upT = (LAS bf16_t*)(lds + 88064); LAS bf16_t* dnA = (LAS bf16_t*)(lds + 93184);
    LAS float* bias_s = (LAS float*)(lds + 98304); LAS float* dk_s = bias_s + 64; LAS float* tot_s = dk_s + 64;
    LAS bf16_t* laT_hi = (LAS bf16_t*)(lds + 99328); LAS bf16_t* laT_lo = laT_hi + 4608; LAS bf16_t* Lm = laT_lo + 4608;
    for (int w = BID(); w < 256; w += NBLK()) {
        const int vh = w & 1, dir = (w >> 1) & 1, h = (w >> 2) & 3, b = w >> 4;
        const float* up = (dir ? INP(p, 9) : INP(p, 7)) + (size_t)l * 16 * 256; const float* bias = (dir ? INP(p, 10) : INP(p, 8)) + (size_t)l * 256;
        bf16_t* O = dir ? (bf16_t*)(WSP(p) + WS_H) : (bf16_t*)(WSP(p) + WS_Y);
        __syncthreads();
        for (int i = tid; i < 64 * 40; i += 512) { const int col = i / 40, k = i - col * 40; st_bf(upT + i, (k < 16) ? up[k * 256 + h * 64 + col] : 0.f); st_bf(dnA + i, 0.f); }
        for (int i = tid; i < 64 * 72; i += 512) { const int t = i / 72, ii = i - t * 72; st_bf(Lm + i, (ii <= t && ii < 64) ? 1.0f : 0.f); }
        if (tid < 64) bias_s[tid] = bias[h * 64 + tid];
        for (int i = tid; i < 2304; i += 512) ((LAS unsigned*)stT)[i] = 0u;
        f32x4 sacc[2] = {{0.f, 0.f, 0.f, 0.f}, {0.f, 0.f, 0.f, 0.f}};
        const int ltok = tid >> 3, lc8 = (tid & 7) * 8;
        const int dtok = (tid & 127) >> 1, dc8 = (tid & 1) * 8;
        const int ltokm = dir ? 63 - ltok : ltok, dtokm = dir ? 63 - dtok : dtok;
        const int dncol = dir ? 1552 : 1536;
        const int tr = wid & 3, tcb = (wid >> 2) * 2, r16 = lane & 15, quad = lane >> 4;
        uint4 rq, rk, rv, rd; rd = make_uint4(0, 0, 0, 0);
        {   const int c = dir ? 31 : 0; const size_t tb = (size_t)b * SEQ_ + c * 64;
            const bf16_t* zr = ZG + (tb + ltokm) * ZGC;
            rq = *(const uint4*)(zr + h * 64 + lc8); rk = *(const uint4*)(zr + 256 + h * 64 + lc8); rv = *(const uint4*)(zr + 512 + h * 128 + vh * 64 + lc8);
            if (tid < 128) rd = *(const uint4*)(ZG + (tb + dtokm) * ZGC + dncol + dc8); }
#pragma unroll 1
        for (int ci = 0; ci < 32; ++ci) {
            const int c = dir ? 31 - ci : ci; const size_t t0 = (size_t)b * SEQ_ + c * 64;
            LBAR();
            if (tid < 128) *(LAS u32x4*)(dnA + dtok * 40 + dc8) = (u32x4){rd.x, rd.y, rd.z, rd.w};
            float fq[8], fk[8], fv[8];
            unpack8(rq, fq); unpack8(rk, fk); unpack8(rv, fv);
            if (ci + 1 < 32) {
                const int cn = dir ? 30 - ci : ci + 1; const size_t tb = (size_t)b * SEQ_ + cn * 64;
                const bf16_t* zr = ZG + (tb + ltokm) * ZGC;
                rq = *(const uint4*)(zr + h * 64 + lc8); rk = *(const uint4*)(zr + 256 + h * 64 + lc8); rv = *(const uint4*)(zr + 512 + h * 128 + vh * 64 + lc8);
                if (tid < 128) rd = *(const uint4*)(ZG + (tb + dtokm) * ZGC + dncol + dc8); }
            LBAR();
#pragma unroll
            for (int i = 0; i < 2; ++i) { const int id = wid + 8 * i, rt = id >> 2, ct = id & 3; const f32x4 z4 = {0.f, 0.f, 0.f, 0.f};
                const f32x4 z = mm_nt<1>(dnA, 40, rt * 16, upT, 40, ct * 16, r16, quad, z4);
                const int col = ct * 16 + r16; const float bz = bias_s[col];
                f32x4 la, lo;
#pragma unroll
                for (int j = 0; j < 4; ++j) la[j] = -softplus_(-(z[j] + bz)) * (1.0f / 16.0f);
                const unsigned h01 = cvt_pk_bf16(la[0], la[1]), h23 = cvt_pk_bf16(la[2], la[3]);
                lo[0] = la[0] - bf_lo(h01); lo[1] = la[1] - bf_hi(h01); lo[2] = la[2] - bf_lo(h23); lo[3] = la[3] - bf_hi(h23);
                u32x2 hw; hw.x = h01; hw.y = h23; *(LAS u32x2*)(laT_hi + col * 72 + rt * 16 + quad * 4) = hw;
                st_bf4(laT_lo + col * 72 + rt * 16 + quad * 4, lo); }
            LBAR();
#pragma unroll
            for (int i = 0; i < 2; ++i) { const int id = wid + 8 * i, rt = id >> 2, ct = id & 3; const f32x4 z4 = {0.f, 0.f, 0.f, 0.f};
                f32x4 acc = mm_nt<2>(Lm, 72, rt * 16, laT_hi, 72, ct * 16, r16, quad, z4);
                acc = mm_nt<2>(Lm, 72, rt * 16, laT_lo, 72, ct * 16, r16, quad, acc);
                const int col = ct * 16 + r16;
#pragma unroll
                for (int j = 0; j < 4; ++j) b_s[(rt * 16 + quad * 4 + j) * 64 + col] = acc[j];
                if (rt == 3 && quad == 3) { tot_s[col] = acc[3]; dk_s[col] = __expf(acc[3]); } }
            LBAR();
            {   const f32x4 b0 = *(const LAS f32x4*)(b_s + ltok * 64 + lc8), b1 = *(const LAS f32x4*)(b_s + ltok * 64 + lc8 + 4);
                const f32x4 d0 = *(const LAS f32x4*)(dk_s + lc8), d1 = *(const LAS f32x4*)(dk_s + lc8 + 4);
                float qv[8], kv[8], ktv[8];
#pragma unroll
                for (int j = 0; j < 8; ++j) {
                    const float bb = (j < 4) ? b0[j & 3] : b1[j & 3], dkj = (j < 4) ? d0[j & 3] : d1[j & 3];
                    const float e = __expf(bb), einv = __builtin_amdgcn_rcpf(e);
                    qv[j] = fq[j] * 0.125f * e; kv[j] = fk[j] * einv;
                    ktv[j] = kv[j] * dkj;
                }
                const uint4 q4 = pack8(qv), k4 = pack8(kv), t4 = pack8(ktv), v4 = pack8(fv);
                *(LAS u32x4*)(qd + ltok * 72 + lc8) = (u32x4){q4.x, q4.y, q4.z, q4.w}; *(LAS u32x4*)(kd + ltok * 72 + lc8) = (u32x4){k4.x, k4.y, k4.z, k4.w};
                *(LAS u32x4*)(ktT + ltok * 72 + lc8) = (u32x4){t4.x, t4.y, t4.z, t4.w}; *(LAS u32x4*)(vT + ltok * 72 + lc8) = (u32x4){v4.x, v4.y, v4.z, v4.w}; }
            LBAR();
            f32x4 oacc[2] = {{0.f, 0.f, 0.f, 0.f}, {0.f, 0.f, 0.f, 0.f}};
            {
                f32x4 sc[2] = {{0.f, 0.f, 0.f, 0.f}, {0.f, 0.f, 0.f, 0.f}};
                const f32x4 dkv = *(const LAS f32x4*)(dk_s + tr * 16 + quad * 4);
                sacc[0] *= dkv; sacc[1] *= dkv;
                const int arow = (tr * 16 + r16) * 72 + quad * 8;
#pragma unroll
                for (int ks = 0; ks < 2; ++ks) {
                    const bf16x8 a_kd = *(const LAS bf16x8*)(kd + arow + ks * 32), a_st = *(const LAS bf16x8*)(stT + arow + ks * 32), a_kt = trfrag(ktT, 72, ks * 32, tr * 16, lane);
#pragma unroll
                    for (int t = 0; t < 2; ++t) { const int brow = ((tcb + t) * 16 + r16) * 72 + ks * 32 + quad * 8;
                        const bf16x8 b_qd = *(const LAS bf16x8*)(qd + brow), b_vT = trfrag(vT, 72, ks * 32, (tcb + t) * 16, lane);
                        sc[t] = __builtin_amdgcn_mfma_f32_16x16x32_bf16(a_kd, b_qd, sc[t], 0, 0, 0);
                        oacc[t] = __builtin_amdgcn_mfma_f32_16x16x32_bf16(a_st, b_qd, oacc[t], 0, 0, 0);
                        sacc[t] = __builtin_amdgcn_mfma_f32_16x16x32_bf16(a_kt, b_vT, sacc[t], 0, 0, 0); } }
#pragma unroll
                for (int t = 0; t < 2; ++t) { const int lrow = (tcb + t) * 16 + r16; float pv[4];
#pragma unroll
                    for (int j = 0; j < 4; ++j) { const int m = tr * 16 + quad * 4 + j; const bool keep = dir ? (lrow > m) : (lrow >= m); pv[j] = keep ? sc[t][j] : 0.f; }
                    u32x2 pw; pw.x = cvt_pk_bf16(pv[0], pv[1]); pw.y = cvt_pk_bf16(pv[2], pv[3]);
                    *(LAS u32x2*)(Pm + lrow * 72 + tr * 16 + quad * 4) = pw; } }
            LBAR();
            {
                const int arow = (tr * 16 + r16) * 72 + quad * 8;
#pragma unroll
                for (int ks = 0; ks < 2; ++ks) { const bf16x8 a_v = trfrag(vT, 72, ks * 32, tr * 16, lane);
#pragma unroll
                    for (int t = 0; t < 2; ++t) { const bf16x8 b_P = *(const LAS bf16x8*)(Pm + ((tcb + t) * 16 + r16) * 72 + ks * 32 + quad * 8);
                        oacc[t] = __builtin_amdgcn_mfma_f32_16x16x32_bf16(a_v, b_P, oacc[t], 0, 0, 0); } }
#pragma unroll
                for (int t = 0; t < 2; ++t) { const int cr = (tcb + t) * 16 + r16;
                    *(LAS f32x4*)(o_s + cr * 64 + tr * 16 + quad * 4) = oacc[t];
                    u32x2 sw; sw.x = cvt_pk_bf16(sacc[t][0], sacc[t][1]); sw.y = cvt_pk_bf16(sacc[t][2], sacc[t][3]);
                    *(LAS u32x2*)(stT + cr * 72 + tr * 16 + quad * 4) = sw; } }
            LBAR();
            {   float f[8];
#pragma unroll
                for (int j = 0; j < 8; ++j) f[j] = o_s[ltok * 64 + lc8 + j];
                *(uint4*)(O + (t0 + ltokm) * 512 + h * 128 + vh * 64 + lc8) = pack8(f); }
        }
    }
}

__device__ void gla_post_phase(const Params& p, int l) {
    const int gtid = BID() * 512 + TID(), gsz = NBLK() * 512;
    const bf16_t* ZG = (const bf16_t*)(WSP(p) + WS_R + R_ZG); bf16_t* OF = (bf16_t*)(WSP(p) + WS_Y); const bf16_t* OB = (const bf16_t*)(WSP(p) + WS_H);
    const float* gn = INP(p, 11) + (size_t)l * 512;
    for (int idx = gtid; idx < T_ * 64; idx += gsz) {
        const int sub = idx & 15, th = idx >> 4, h = th & 3; const size_t t = (size_t)(th >> 2); const int col = h * 128 + sub * 8;
        float of[8], ob[8], r[8], y[8];
        unpack8(*(const uint4*)(OF + t * 512 + col), of); unpack8(*(const uint4*)(OB + t * 512 + col), ob); unpack8(*(const uint4*)(ZG + t * ZGC + 1024 + col), r);
        float ss = 0.f;
#pragma unroll
        for (int j = 0; j < 8; ++j) { of[j] += ob[j]; ss += of[j] * of[j]; }
        ss = red16(ss);
        const float rs = rsqrtf(ss * (1.0f / 128.0f) + 1e-6f);
#pragma unroll
        for (int j = 0; j < 8; ++j) y[j] = of[j] * rs * gn[col + j] * (r[j] * sigmoid_(r[j]));
        *(uint4*)(OF + t * 512 + col) = pack8(y);
    }
}


struct RwOps { f32x4 w0, w1, c0, c1, e0, e1, d0, d1, r0, r1; float vv; };
__device__ __forceinline__ RwOps rw_load(const LAS float* w_s, int s, int v, int ko) {
    RwOps o; const LAS float* b = w_s + s * 64 + ko * 8;
    o.w0 = *(const LAS f32x4*)(b); o.w1 = *(const LAS f32x4*)(b + 4);
    o.c0 = *(const LAS f32x4*)(b + 2048); o.c1 = *(const LAS f32x4*)(b + 2052);
    o.e0 = *(const LAS f32x4*)(b + 4096); o.e1 = *(const LAS f32x4*)(b + 4100);
    o.d0 = *(const LAS f32x4*)(b + 6144); o.d1 = *(const LAS f32x4*)(b + 6148);
    o.r0 = *(const LAS f32x4*)(b + 8192); o.r1 = *(const LAS f32x4*)(b + 8196);
    o.vv = w_s[10240 + s * 64 + v]; return o;
}
typedef float f2v __attribute__((ext_vector_type(2)));
__device__ __forceinline__ float dot8(const f2v (&S)[4], const f32x4 a, const f32x4 b) {
    f2v acc = S[0] * (f2v){a[0], a[1]};
    acc = S[1] * (f2v){a[2], a[3]} + acc;
    acc = S[2] * (f2v){b[0], b[1]} + acc;
    acc = S[3] * (f2v){b[2], b[3]} + acc;
    return acc.x + acc.y;
}
template <int DIR> __device__ __forceinline__ void rw_step(f2v (&S)[4], const RwOps& p, LAS float* y_s, int s, int v) {
    float y = 0.f;
    if (DIR) y = dot8(S, p.r0, p.r1);
    const float sa = -red8(dot8(S, p.c0, p.c1));
    const f2v sa2 = {sa, sa}, vv2 = {p.vv, p.vv};
    S[0] = S[0] * (f2v){p.w0[0], p.w0[1]} + ((f2v){p.e0[0], p.e0[1]} * sa2 + (f2v){p.d0[0], p.d0[1]} * vv2);
    S[1] = S[1] * (f2v){p.w0[2], p.w0[3]} + ((f2v){p.e0[2], p.e0[3]} * sa2 + (f2v){p.d0[2], p.d0[3]} * vv2);
    S[2] = S[2] * (f2v){p.w1[0], p.w1[1]} + ((f2v){p.e1[0], p.e1[1]} * sa2 + (f2v){p.d1[0], p.d1[1]} * vv2);
    S[3] = S[3] * (f2v){p.w1[2], p.w1[3]} + ((f2v){p.e1[2], p.e1[3]} * sa2 + (f2v){p.d1[2], p.d1[3]} * vv2);
    if (!DIR) y = dot8(S, p.r0, p.r1);
    y = red8(y);
    y_s[s * 64 + v] = y;
}
template <int DIR> __device__ __forceinline__ void rwkv_steps(f2v (&S)[4], LAS float* w_s, int v, int ko) {
    LAS float* y_s = w_s + 12288;
    RwOps a = rw_load(w_s, DIR ? 31 : 0, v, ko);
#pragma unroll 1
    for (int si = 0; si < 32; si += 2) {
        const int s0 = DIR ? 31 - si : si, s1 = DIR ? 30 - si : si + 1, s2 = DIR ? (si < 30 ? 29 - si : 0) : (si < 30 ? si + 2 : 31);
        const RwOps b = rw_load(w_s, s1, v, ko);
        rw_step<DIR>(S, a, y_s, s0, v);
        a = rw_load(w_s, s2, v, ko);
        rw_step<DIR>(S, b, y_s, s1, v);
    }
}

__device__ __forceinline__ int rwkv_col(int cg, int h, int dir) {
    if (cg < 4) return h * 64 + cg * 16;
    if (cg < 8) return 512 + h * 64 + (cg - 4) * 16;
    if (cg < 12) return 1024 + h * 64 + (cg - 8) * 16;
    if (cg < 14) return (dir ? 1568 : 1536) + (cg - 12) * 16;
    return (dir ? 1632 : 1600) + (cg - 14) * 16;
}
__device__ void rwkv_scan_phase(const Params& p, int l, LAS unsigned char* lds) {
    const int tid = TID();
    const bf16_t* ZR = (const bf16_t*)(WSP(p) + WS_R + R_ZR);
    float* BON = (float*)(WSP(p) + WS_BON);
    LAS float* sh_s = (LAS float*)lds;
    LAS float* w_s = sh_s + 8192; LAS float* kk_s = w_s + 2048; LAS float* kka_s = kk_s + 2048; LAS float* kd_s = kka_s + 2048; LAS float* r_s = kd_s + 2048; LAS float* v_s = r_s + 2048;
    LAS float* y_s = v_s + 2048; LAS float* w2_s = y_s + 2048; LAS float* a2_s = w2_s + 2048; LAS float* c_s = a2_s + 2048; LAS float* mu_s = c_s + 320;
    const float* mu = INP(p, 12) + (size_t)l * ZRC;
    for (int w = BID(); w < 256; w += NBLK()) {
        const int dir = w & 1, h = (w >> 1) & 7, b = w >> 4;
        const float* w0 = (dir ? INP(p, 15) : INP(p, 13)) + (size_t)l * 512; const float* w2 = (dir ? INP(p, 16) : INP(p, 14)) + (size_t)l * 32 * 512;
        const float* a0 = (dir ? INP(p, 19) : INP(p, 17)) + (size_t)l * 512; const float* a2 = (dir ? INP(p, 20) : INP(p, 18)) + (size_t)l * 32 * 512;
        bf16_t* Y = dir ? (bf16_t*)(WSP(p) + WS_R + R_FT) : (bf16_t*)(WSP(p) + WS_Y + 2 * Y_STRIDE);
        const int tok = tid >> 4, cg = tid & 15, zc = rwkv_col(cg, h, dir);
        __syncthreads();
        for (int i = tid; i < 2048; i += 512) { w2_s[i] = w2[(i >> 6) * 512 + h * 64 + (i & 63)]; a2_s[i] = a2[(i >> 6) * 512 + h * 64 + (i & 63)]; }
        if (tid < 64) { c_s[tid] = w0[h * 64 + tid]; c_s[64 + tid] = a0[h * 64 + tid]; c_s[128 + tid] = INP(p, 22)[(size_t)l * 512 + h * 64 + tid];
                        c_s[192 + tid] = INP(p, 23)[(size_t)l * 512 + h * 64 + tid]; c_s[256 + tid] = INP(p, 24)[(size_t)l * 512 + h * 64 + tid]; }
        if (tid < 256) mu_s[tid] = mu[rwkv_col(tid >> 4, h, dir) + (tid & 15)];
        f2v S[4];
#pragma unroll
        for (int j = 0; j < 4; ++j) S[j] = (f2v){0.f, 0.f};
        const int v = tid >> 3, ko = tid & 7;
        uint4 rp[2], rc[2], rn[2];
#define RW_LOAD(cidx) do { const int s_ = (cidx) * 32 + tok; const bf16_t* zp = ZR + ((size_t)b * SEQ_ + s_) * ZRC + zc; \
            rc[0] = *(const uint4*)zp; rc[1] = *(const uint4*)(zp + 8); \
            if (s_ > 0) { rp[0] = *(const uint4*)(zp - ZRC); rp[1] = *(const uint4*)(zp - ZRC + 8); } else { rp[0] = make_uint4(0, 0, 0, 0); rp[1] = rp[0]; } \
            if (s_ < SEQ_ - 1) { rn[0] = *(const uint4*)(zp + ZRC); rn[1] = *(const uint4*)(zp + ZRC + 8); } else { rn[0] = make_uint4(0, 0, 0, 0); rn[1] = rn[0]; } } while (0)
        RW_LOAD(dir ? 63 : 0);
        for (int ci = 0; ci < 64; ++ci) {
            const int c = dir ? 63 - ci : ci; const size_t t0 = (size_t)b * SEQ_ + c * 32;
            __syncthreads();
#pragma unroll
            for (int hf = 0; hf < 2; ++hf) { float fc[8], fp[8], fn[8]; unpack8(rc[hf], fc); unpack8(rp[hf], fp); unpack8(rn[hf], fn);
#pragma unroll
                for (int j = 0; j < 8; ++j) { const int vc = cg * 16 + hf * 8 + j; float x = fc[j] + mu_s[vc] * (0.5f * (fp[j] + fn[j]) - fc[j]);
                    if (cg == 12 || cg == 13) x = tanh_(x);
                    sh_s[tok * 256 + vc] = x; } }
            __syncthreads();
            {
                const int j0 = cg * 4;
                float wp[4], ap[4];
#pragma unroll
                for (int j = 0; j < 4; ++j) { wp[j] = c_s[j0 + j]; ap[j] = c_s[64 + j0 + j]; }
#pragma unroll 8
                for (int i = 0; i < 32; ++i) { const float tw = sh_s[tok * 256 + 192 + i], ta = sh_s[tok * 256 + 224 + i];
                    const f32x4 w2v = *(const LAS f32x4*)(w2_s + i * 64 + j0), a2v = *(const LAS f32x4*)(a2_s + i * 64 + j0);
#pragma unroll
                    for (int j = 0; j < 4; ++j) { wp[j] += tw * w2v[j]; ap[j] += ta * a2v[j]; } }
                f32x4 rv4 = *(const LAS f32x4*)(sh_s + tok * 256 + j0), kv4 = *(const LAS f32x4*)(sh_s + tok * 256 + 64 + j0), vv4 = *(const LAS f32x4*)(sh_s + tok * 256 + 128 + j0);
                f32x4 wv, kkv, kkav, kdv; float ss = 0.f, bs = 0.f;
#pragma unroll
                for (int j = 0; j < 4; ++j) { kkv[j] = kv4[j] * c_s[128 + j0 + j]; ss += kkv[j] * kkv[j]; }
                ss = red16(ss);
                const float rn_ = rsqrtf(ss + 1e-12f);
#pragma unroll
                for (int j = 0; j < 4; ++j) {
                    const float a = sigmoid_(ap[j]);
                    wv[j] = __expf(-__expf(-softplus_(-wp[j]) - 0.5f));
                    kkv[j] *= rn_; kkav[j] = kkv[j] * a;
                    kdv[j] = kv4[j] * (1.0f + (a - 1.0f) * c_s[192 + j0 + j]);
                    bs += rv4[j] * kdv[j] * c_s[256 + j0 + j];
                }
                bs = red16(bs);
                if (dir == 0 && cg == 0) BON[(t0 + tok) * 8 + h] = bs;
                *(LAS f32x4*)(w_s + tok * 64 + j0) = wv; *(LAS f32x4*)(kk_s + tok * 64 + j0) = kkv; *(LAS f32x4*)(kka_s + tok * 64 + j0) = kkav;
                *(LAS f32x4*)(kd_s + tok * 64 + j0) = kdv; *(LAS f32x4*)(r_s + tok * 64 + j0) = rv4; *(LAS f32x4*)(v_s + tok * 64 + j0) = vv4;
            }
            if (ci + 1 < 64) { RW_LOAD(dir ? 62 - ci : ci + 1); }
            __syncthreads();
            if (dir) rwkv_steps<1>(S, w_s, v, ko); else rwkv_steps<0>(S, w_s, v, ko);
            __syncthreads();
            {   const f32x4 yv = *(const LAS f32x4*)(y_s + tok * 64 + cg * 4);
                u32x2 wv2; wv2.x = cvt_pk_bf16(yv[0], yv[1]); wv2.y = cvt_pk_bf16(yv[2], yv[3]);
                *(u32x2*)(Y + (t0 + tok) * 512 + h * 64 + cg * 4) = wv2; }
        }
#undef RW_LOAD
    }
}


__device__ void rwkv_chunk_phase(const Params& p, int l, LAS unsigned char* lds) {
    const int tid = TID(), lane = tid & 63, wid = tid >> 6, r16 = lane & 15, quad = lane >> 4;
    const bf16_t* ZR = (const bf16_t*)(WSP(p) + WS_R + R_ZR);
    float* BON = (float*)(WSP(p) + WS_BON);
    LAS bf16_t* w2T = (LAS bf16_t*)lds; LAS bf16_t* a2T = w2T + 2560; LAS float* c_s = (LAS float*)(lds + 16384); LAS float* mu_s = c_s + 320; LAS float* gL_s = mu_s + 256; LAS float* part_s = gL_s + 64;
    LAS float* lg_s = (LAS float*)(lds + 20992); LAS float* y_s = (LAS float*)(lds + 29184);
    LAS bf16_t* S0b[2] = {(LAS bf16_t*)(lds + 37376), (LAS bf16_t*)(lds + 46592)};
    LAS bf16_t* G1 = (LAS bf16_t*)(lds + 55808);
    LAS bf16_t* Ct = (LAS bf16_t*)(lds + 65024); LAS bf16_t* Bt = Ct + 2304; LAS bf16_t* Kt = Bt + 2304; LAS bf16_t* Rt = Kt + 2304; LAS bf16_t* B1 = Rt + 2304;
    LAS bf16_t* CtT = (LAS bf16_t*)(lds + 88064); LAS bf16_t* BgT = CtT + 2560; LAS bf16_t* KgT = BgT + 2560; LAS bf16_t* VtT = KgT + 2560; LAS bf16_t* W2 = VtT + 2560; LAS bf16_t* G2m = W2 + 2560;
    LAS float* sh_s = (LAS float*)(lds + 118784);
    LAS bf16_t* Pq[2] = {(LAS bf16_t*)(lds + 118784), (LAS bf16_t*)(lds + 118784 + 5120)}; LAS bf16_t* PTq[2] = {Pq[0] + 1280, Pq[1] + 1280};
    LAS bf16_t* Tq[2] = {(LAS bf16_t*)(lds + 118784 + 10240), (LAS bf16_t*)(lds + 118784 + 12800)};
    LAS bf16_t* TT = (LAS bf16_t*)(lds + 118784 + 15360); LAS bf16_t* QTT = TT + 1280; LAS bf16_t* MKT = QTT + 1280; LAS bf16_t* MBT = MKT + 1280; LAS bf16_t* W1 = MBT + 1280; LAS bf16_t* B2 = W1 + 1280;
    LAS float* lgp_s = (LAS float*)(lds + 55808);
    LAS bf16_t* lwT_hi = (LAS bf16_t*)(lds + 113664); LAS bf16_t* lwT_lo = CtT;
    LAS bf16_t* L32 = (LAS bf16_t*)(lds + 83456); LAS float* tot_s = part_s;
    const float* mu = INP(p, 12) + (size_t)l * ZRC;
    for (int w = BID(); w < 256; w += NBLK()) {
        const int dir = w & 1, h = (w >> 1) & 7, b = w >> 4;
        const float* w0 = (dir ? INP(p, 15) : INP(p, 13)) + (size_t)l * 512; const float* w2 = (dir ? INP(p, 16) : INP(p, 14)) + (size_t)l * 32 * 512;
        const float* a0 = (dir ? INP(p, 19) : INP(p, 17)) + (size_t)l * 512; const float* a2 = (dir ? INP(p, 20) : INP(p, 18)) + (size_t)l * 32 * 512;
        bf16_t* Y = dir ? (bf16_t*)(WSP(p) + WS_R + R_FT) : (bf16_t*)(WSP(p) + WS_Y + 2 * Y_STRIDE);
        const int tok = tid >> 4, cg = tid & 15, zc = rwkv_col(cg, h, dir), j0 = cg * 4;
        const int tokm = dir ? 31 - tok : tok;
        __syncthreads();
        for (int i = tid; i < 2048; i += 512) { const int ii = i >> 6, jj = i & 63; st_bf(w2T + jj * 40 + ii, w2[ii * 512 + h * 64 + jj]); st_bf(a2T + jj * 40 + ii, a2[ii * 512 + h * 64 + jj]); }
        if (tid < 64) { c_s[tid] = w0[h * 64 + tid]; c_s[64 + tid] = a0[h * 64 + tid]; c_s[128 + tid] = INP(p, 22)[(size_t)l * 512 + h * 64 + tid];
                        c_s[192 + tid] = INP(p, 23)[(size_t)l * 512 + h * 64 + tid]; c_s[256 + tid] = INP(p, 24)[(size_t)l * 512 + h * 64 + tid]; }
        if (tid < 256) mu_s[tid] = mu[rwkv_col(tid >> 4, h, dir) + (tid & 15)];
        for (int i = tid; i < 2304; i += 512) ((LAS unsigned*)S0b[0])[i] = 0u;
        for (int i = tid; i < 32 * 40; i += 512) { const int t = i / 40, ii = i - t * 40; st_bf(L32 + i, (ii <= t && ii < 32) ? 1.0f : 0.f); }
        uint4 rp[2], rc[2], rn[2];
#define RW_LOAD(cidx) do { const int s_ = (cidx) * 32 + tokm; const bf16_t* zp = ZR + ((size_t)b * SEQ_ + s_) * ZRC + zc; \
            rc[0] = *(const uint4*)zp; rc[1] = *(const uint4*)(zp + 8); \
            if (s_ > 0) { rp[0] = *(const uint4*)(zp - ZRC); rp[1] = *(const uint4*)(zp - ZRC + 8); } else { rp[0] = make_uint4(0, 0, 0, 0); rp[1] = rp[0]; } \
            if (s_ < SEQ_ - 1) { rn[0] = *(const uint4*)(zp + ZRC); rn[1] = *(const uint4*)(zp + ZRC + 8); } else { rn[0] = make_uint4(0, 0, 0, 0); rn[1] = rn[0]; } } while (0)
        RW_LOAD(dir ? 63 : 0);
        int cur = 0;
#pragma unroll 1
        for (int ci = 0; ci < 64; ++ci) {
            const int c = dir ? 63 - ci : ci; const size_t t0 = (size_t)b * SEQ_ + c * 32;
            LBAR();
            f32x4 lw4, kk4, b4, kd4, r4, v4;
            for (int rp_ = 0; rp_ < STG_REP; ++rp_) {
            if (rp_) LBAR();
#pragma unroll
            for (int hf = 0; hf < 2; ++hf) { float fc[8], fp[8], fn[8]; unpack8(rc[hf], fc); unpack8(rp[hf], fp); unpack8(rn[hf], fn);
                const f32x4 m0 = *(const LAS f32x4*)(mu_s + cg * 16 + hf * 8), m1 = *(const LAS f32x4*)(mu_s + cg * 16 + hf * 8 + 4);
                f32x4 x0, x1;
#pragma unroll
                for (int j = 0; j < 4; ++j) { x0[j] = fc[j] + m0[j] * (0.5f * (fp[j] + fn[j]) - fc[j]); x1[j] = fc[4 + j] + m1[j] * (0.5f * (fp[4 + j] + fn[4 + j]) - fc[4 + j]); }
                *(LAS f32x4*)(sh_s + tok * 256 + cg * 16 + hf * 8) = x0; *(LAS f32x4*)(sh_s + tok * 256 + cg * 16 + hf * 8 + 4) = x1; }
            LBAR();
            {   const int rt = wid >> 2, ct = wid & 3, row = rt * 16 + r16;
                const f32x4 d0 = *(const LAS f32x4*)(sh_s + row * 256 + 192 + quad * 8), d1 = *(const LAS f32x4*)(sh_s + row * 256 + 196 + quad * 8);
                const f32x4 e0 = *(const LAS f32x4*)(sh_s + row * 256 + 224 + quad * 8), e1 = *(const LAS f32x4*)(sh_s + row * 256 + 228 + quad * 8);
                u32x4 aw, aa;
                aw.x = cvt_pk_bf16(tanh_(d0[0]), tanh_(d0[1])); aw.y = cvt_pk_bf16(tanh_(d0[2]), tanh_(d0[3])); aw.z = cvt_pk_bf16(tanh_(d1[0]), tanh_(d1[1])); aw.w = cvt_pk_bf16(tanh_(d1[2]), tanh_(d1[3]));
                aa.x = cvt_pk_bf16(e0[0], e0[1]); aa.y = cvt_pk_bf16(e0[2], e0[3]); aa.z = cvt_pk_bf16(e1[0], e1[1]); aa.w = cvt_pk_bf16(e1[2], e1[3]);
                const bf16x8 bw = *(const LAS bf16x8*)(w2T + (ct * 16 + r16) * 40 + quad * 8), ba = *(const LAS bf16x8*)(a2T + (ct * 16 + r16) * 40 + quad * 8);
                const f32x4 z4 = {0.f, 0.f, 0.f, 0.f};
                const f32x4 cw = __builtin_amdgcn_mfma_f32_16x16x32_bf16(__builtin_bit_cast(bf16x8, aw), bw, z4, 0, 0, 0);
                const f32x4 ca = __builtin_amdgcn_mfma_f32_16x16x32_bf16(__builtin_bit_cast(bf16x8, aa), ba, z4, 0, 0, 0);
                const int col = ct * 16 + r16; const float w0c = c_s[col], a0c = c_s[64 + col];
                f32x4 lwv, lo;
#pragma unroll
                for (int j = 0; j < 4; ++j) { const int tr_ = rt * 16 + quad * 4 + j; lwv[j] = -__expf(-softplus_(-(cw[j] + w0c)) - 0.5f); y_s[tr_ * 64 + col] = lwv[j]; lg_s[tr_ * 64 + col] = ca[j] + a0c; }
                const unsigned h01 = cvt_pk_bf16(lwv[0], lwv[1]), h23 = cvt_pk_bf16(lwv[2], lwv[3]);
                lo[0] = lwv[0] - bf_lo(h01); lo[1] = lwv[1] - bf_hi(h01); lo[2] = lwv[2] - bf_lo(h23); lo[3] = lwv[3] - bf_hi(h23);
                u32x2 hw; hw.x = h01; hw.y = h23; *(LAS u32x2*)(lwT_hi + col * 40 + rt * 16 + quad * 4) = hw; st_bf4(lwT_lo + col * 40 + rt * 16 + quad * 4, lo); }
            LBAR();
            {   const f32x4 wp = *(const LAS f32x4*)(y_s + tok * 64 + j0), ap = *(const LAS f32x4*)(lg_s + tok * 64 + j0);
                r4 = *(const LAS f32x4*)(sh_s + tok * 256 + j0); const f32x4 kv4 = *(const LAS f32x4*)(sh_s + tok * 256 + 64 + j0); v4 = *(const LAS f32x4*)(sh_s + tok * 256 + 128 + j0);
                float ss = 0.f, bs = 0.f;
#pragma unroll
                for (int j = 0; j < 4; ++j) { kk4[j] = kv4[j] * c_s[128 + j0 + j]; ss += kk4[j] * kk4[j]; }
                ss = red16d(ss);
                const float rn_ = rsqrtf(ss + 1e-12f);
#pragma unroll
                for (int j = 0; j < 4; ++j) {
                    const float a = sigmoid_(ap[j]);
                    lw4[j] = wp[j];
                    kk4[j] *= rn_; b4[j] = kk4[j] * a;
                    kd4[j] = kv4[j] * (1.0f + (a - 1.0f) * c_s[192 + j0 + j]);
                    bs += r4[j] * kd4[j] * c_s[256 + j0 + j];
                }
                bs = red16d(bs);
                if (dir == 0 && cg == 0) BON[(t0 + tokm) * 8 + h] = bs;
            }
            {
                const int rt = wid >> 2, ct = wid & 3; const f32x4 z4 = {0.f, 0.f, 0.f, 0.f};
                f32x4 acc = mm_nt<1>(L32, 40, rt * 16, lwT_hi, 40, ct * 16, r16, quad, z4);
                acc = mm_nt<1>(L32, 40, rt * 16, lwT_lo, 40, ct * 16, r16, quad, acc);
                const int col = ct * 16 + r16;
#pragma unroll
                for (int j = 0; j < 4; ++j) lgp_s[(rt * 16 + quad * 4 + j) * 64 + col] = acc[j];
                if (rt == 1 && quad == 3) { tot_s[col] = acc[3]; gL_s[col] = __expf(acc[3]); } }
            if (ci + 1 < 64 && rp_ == STG_REP - 1) { RW_LOAD(dir ? 62 - ci : ci + 1); }
            LBAR();
            {   const f32x4 lgl = *(const LAS f32x4*)(lgp_s + tok * 64 + j0), tot = *(const LAS f32x4*)(tot_s + j0);
                f32x4 ctv, btv, ktv, rtv, bgv, kgv;
#pragma unroll
                for (int j = 0; j < 4; ++j) {
                    const float lg = lgl[j], lgp = lg - lw4[j];
                    const float einv = __expf(-lg), eL = __expf(tot[j] - lg);
                    ctv[j] = kk4[j] * __expf(lgp); btv[j] = b4[j] * einv; ktv[j] = kd4[j] * einv; rtv[j] = r4[j] * __expf(dir ? lgp : lg);
                    bgv[j] = b4[j] * eL; kgv[j] = kd4[j] * eL;
                }
                st_bf4(Ct + tok * 72 + j0, ctv); st_bf4(Bt + tok * 72 + j0, btv); st_bf4(Kt + tok * 72 + j0, ktv); st_bf4(Rt + tok * 72 + j0, rtv);
                st_bf4(BgT + tok * 72 + j0, bgv); st_bf4(KgT + tok * 72 + j0, kgv); st_bf4(VtT + tok * 72 + j0, v4);
            }
            }
            LBAR();
#pragma unroll
            for (int i = 0; i < 2; ++i) { const int id = wid + 8 * i, pr = id >> 2, rt = (id >> 1) & 1, ct = id & 1;
                const LAS bf16_t* X = (pr < 2) ? Ct : Rt; const LAS bf16_t* Yo = (pr == 0 || pr == 3) ? Bt : Kt;
                const f32x4 z4 = {0.f, 0.f, 0.f, 0.f};
                f32x4 acc = mm_nt<2>(X, 72, rt * 16, Yo, 72, ct * 16, r16, quad, z4);
                const int col = ct * 16 + r16, rb = rt * 16 + quad * 4;
                const bool strictm = (pr < 2) || dir;
#pragma unroll
                for (int j = 0; j < 4; ++j) { const int row = rb + j; const bool keep = strictm ? (row > col) : (row >= col); acc[j] = keep ? acc[j] : 0.f; }
                if (pr == 0) { f32x4 t0v;
#pragma unroll
                    for (int j = 0; j < 4; ++j) t0v[j] = ((rb + j) == col ? 1.0f : 0.0f) - acc[j];
                    const f32x4 na = -acc; st_bf4(PTq[0] + col * 40 + rb, na); st_bf4(Tq[0] + col * 40 + rb, t0v); }
                else { LAS bf16_t* D = (pr == 1) ? QTT : ((pr == 2) ? MKT : MBT); st_bf4(D + col * 40 + rb, acc); } }
            LBAR();
            {   const int rt = wid >> 2, ct = wid & 3; const f32x4 z4 = {0.f, 0.f, 0.f, 0.f};
                f32x4 acc = mm_nt<2>(Ct, 72, rt * 16, S0b[cur], 72, ct * 16, r16, quad, z4);
                acc = __builtin_amdgcn_mfma_f32_16x16x32_bf16(trfrag(QTT, 40, 0, rt * 16, lane), trfrag(VtT, 72, 0, ct * 16, lane), acc, 0, 0, 0);
                st_bf4(CtT + (ct * 16 + r16) * 40 + rt * 16 + quad * 4, acc); }
            if (wid < 4) { const int rt = wid >> 1, ct = wid & 1; const f32x4 z4 = {0.f, 0.f, 0.f, 0.f};
                const f32x4 acc = __builtin_amdgcn_mfma_f32_16x16x32_bf16(trfrag(PTq[0], 40, 0, rt * 16, lane), *(const LAS bf16x8*)(PTq[0] + (ct * 16 + r16) * 40 + quad * 8), z4, 0, 0, 0);
                st_bf4(PTq[1] + (ct * 16 + r16) * 40 + rt * 16 + quad * 4, acc); }
            LBAR();
#pragma unroll
            for (int st = 0; st < 3; ++st) { const int pi = (st & 1) ? 0 : 1, ti = st & 1;
                const int rt = (wid >> 1) & 1, ct = wid & 1; const f32x4 z4 = {0.f, 0.f, 0.f, 0.f};
                const int col = ct * 16 + r16, rb = rt * 16 + quad * 4;
                const bf16x8 yb = *(const LAS bf16x8*)(PTq[pi] + col * 40 + quad * 8);
                if (wid < 4) { const f32x4 acc = __builtin_amdgcn_mfma_f32_16x16x32_bf16(trfrag(PTq[pi], 40, 0, rt * 16, lane), yb, z4, 0, 0, 0);
                    st_bf4(PTq[pi ^ 1] + col * 40 + rb, acc); }
                else { f32x4 acc = __builtin_amdgcn_mfma_f32_16x16x32_bf16(trfrag(Tq[ti], 40, 0, rt * 16, lane), yb, z4, 0, 0, 0);
                    const u32x2 tw = *(const LAS u32x2*)(Tq[ti] + col * 40 + rb);
                    acc[0] += bf_lo(tw.x); acc[1] += bf_hi(tw.x); acc[2] += bf_lo(tw.y); acc[3] += bf_hi(tw.y);
                    st_bf4(Tq[ti ^ 1] + col * 40 + rb, acc); }
                LBAR(); }
            if (wid < 4) { const int rt = wid >> 1, ct = wid & 1; const f32x4 z4 = {0.f, 0.f, 0.f, 0.f};
                const int col = ct * 16 + r16, rb = rt * 16 + quad * 4;
                f32x4 acc = __builtin_amdgcn_mfma_f32_16x16x32_bf16(trfrag(Tq[1], 40, 0, rt * 16, lane), *(const LAS bf16x8*)(PTq[0] + col * 40 + quad * 8), z4, 0, 0, 0);
                const u32x2 tw = *(const LAS u32x2*)(Tq[1] + col * 40 + rb);
                acc[0] += bf_lo(tw.x); acc[1] += bf_hi(tw.x); acc[2] += bf_lo(tw.y); acc[3] += bf_hi(tw.y);
                st_bf4(TT + col * 40 + rb, acc); }
            LBAR();
            {   const int rt = wid >> 2, ct = wid & 3; const f32x4 z4 = {0.f, 0.f, 0.f, 0.f};
                const f32x4 acc = __builtin_amdgcn_mfma_f32_16x16x32_bf16(trfrag(TT, 40, 0, rt * 16, lane), *(const LAS bf16x8*)(CtT + (ct * 16 + r16) * 40 + quad * 8), z4, 0, 0, 0);
                const f32x4 na = -acc; st_bf4(W2 + (ct * 16 + r16) * 40 + rt * 16 + quad * 4, na); }
            LBAR();
            {   const LAS bf16_t* S0 = S0b[cur]; LAS bf16_t* S1 = S0b[cur ^ 1];
#pragma unroll
                for (int i = 0; i < 3; ++i) { const int id = wid + 8 * i; const f32x4 z4 = {0.f, 0.f, 0.f, 0.f};
                    if (id < 8) { const int rt = id >> 2, ct = id & 3;
                        f32x4 acc = mm_nt<2>(Rt, 72, rt * 16, S0, 72, ct * 16, r16, quad, z4);
                        acc = __builtin_amdgcn_mfma_f32_16x16x32_bf16(trfrag(MKT, 40, 0, rt * 16, lane), trfrag(VtT, 72, 0, ct * 16, lane), acc, 0, 0, 0);
                        acc = __builtin_amdgcn_mfma_f32_16x16x32_bf16(trfrag(MBT, 40, 0, rt * 16, lane), *(const LAS bf16x8*)(W2 + (ct * 16 + r16) * 40 + quad * 8), acc, 0, 0, 0);
#pragma unroll
                        for (int j = 0; j < 4; ++j) y_s[(rt * 16 + quad * 4 + j) * 64 + ct * 16 + r16] = acc[j]; }
                    else { const int t = id - 8, rt = t >> 2, ct = t & 3;
                        f32x4 acc = __builtin_amdgcn_mfma_f32_16x16x32_bf16(trfrag(KgT, 72, 0, rt * 16, lane), trfrag(VtT, 72, 0, ct * 16, lane), z4, 0, 0, 0);
                        acc = __builtin_amdgcn_mfma_f32_16x16x32_bf16(trfrag(BgT, 72, 0, rt * 16, lane), *(const LAS bf16x8*)(W2 + (ct * 16 + r16) * 40 + quad * 8), acc, 0, 0, 0);
                        const int kb = rt * 16 + quad * 4, vv_ = ct * 16 + r16;
                        const f32x4 gl = *(const LAS f32x4*)(gL_s + kb);
                        const u32x2 sw = *(const LAS u32x2*)(S0 + vv_ * 72 + kb);
                        acc[0] += gl[0] * bf_lo(sw.x); acc[1] += gl[1] * bf_hi(sw.x); acc[2] += gl[2] * bf_lo(sw.y); acc[3] += gl[3] * bf_hi(sw.y);
                        st_bf4(S1 + vv_ * 72 + kb, acc); } }
                cur ^= 1; }
            LBAR();
            {   const f32x4 yv = *(const LAS f32x4*)(y_s + tok * 64 + cg * 4);
                u32x2 wv2; wv2.x = cvt_pk_bf16(yv[0], yv[1]); wv2.y = cvt_pk_bf16(yv[2], yv[3]);
                *(u32x2*)(Y + (t0 + tokm) * 512 + h * 64 + cg * 4) = wv2; }
        }
#undef RW_LOAD
    }
}

__device__ void rwkv_post_phase(const Params& p, int l, LAS unsigned char* lds) {
    const int tid = TID();
    const bf16_t* ZR = (const bf16_t*)(WSP(p) + WS_R + R_ZR); const float* BON = (const float*)(WSP(p) + WS_BON);
    bf16_t* YF = (bf16_t*)(WSP(p) + WS_Y + 2 * Y_STRIDE); const bf16_t* YBk = (const bf16_t*)(WSP(p) + WS_R + R_FT);
    const float* mu = INP(p, 12) + (size_t)l * ZRC; const float* g2 = INP(p, 21) + (size_t)l * 96 * 512;
    const float* lng = INP(p, 25) + (size_t)l * 512; const float* lnb = INP(p, 26) + (size_t)l * 512;
    const int lane = tid & 63, wid = tid >> 6, r16 = lane & 15, quad = lane >> 4;
    LAS bf16_t* g2T = (LAS bf16_t*)lds;
    LAS bf16_t* sgb = g2T + 512 * 104;
    LAS float* gs = (LAS float*)(lds + 133120);
    __syncthreads();
    for (int idx = tid; idx < 96 * 512; idx += 512) { const int i = idx >> 9, c = idx & 511; st_bf(g2T + c * 104 + i, g2[idx]); }
    for (int base = BID(); base < T_ / 64; base += 2 * NBLK()) {
        const int ntl = (base + NBLK() < T_ / 64) ? 2 : 1;
        __syncthreads();
        for (int tl = 0; tl < ntl; ++tl) {
            const size_t t0 = (size_t)(base + tl * NBLK()) * 64;
            for (int idx = tid; idx < 64 * 96; idx += 512) {
                const int tk = idx / 96, c = idx - tk * 96; const size_t t = t0 + tk; const int s = (int)(t & (SEQ_ - 1));
                const bf16_t* zp = ZR + t * ZRC + 1664 + c;
                const float uc = bf1(zp[0]), up_ = (s > 0) ? bf1(zp[-ZRC]) : 0.f, un = (s < SEQ_ - 1) ? bf1(zp[ZRC]) : 0.f;
                st_bf(sgb + tl * 6656 + tk * 104 + c, sigmoid_(uc + mu[1664 + c] * (0.5f * (up_ + un) - uc)));
            }
        }
        const int tp = tid >> 4, cg = tid & 15;
        for (int h = 0; h < 8; ++h) {
            const int c = h * 64 + cg * 4;
            const f32x4 lg = *(const f32x4*)(lng + c), lb = *(const f32x4*)(lnb + c), m4 = *(const f32x4*)(mu + 1024 + c);
            for (int tl = 0; tl < ntl; ++tl) {
                const size_t t0 = (size_t)(base + tl * NBLK()) * 64;
                __syncthreads();
#pragma unroll
                for (int i = 0; i < 2; ++i) { const int id = wid + 8 * i, rt = id >> 2, ct = id & 3; const f32x4 z4 = {0.f, 0.f, 0.f, 0.f};
                    const f32x4 acc = mm_nt<3>(sgb + tl * 6656, 104, rt * 16, g2T + h * 64 * 104, 104, ct * 16, r16, quad, z4);
#pragma unroll
                    for (int j = 0; j < 4; ++j) gs[(rt * 16 + quad * 4 + j) * 64 + ct * 16 + r16] = acc[j]; }
                __syncthreads();
                const f32x4 gA = *(const LAS f32x4*)(gs + tp * 64 + cg * 4), gB = *(const LAS f32x4*)(gs + (tp + 32) * 64 + cg * 4);
#pragma unroll
                for (int which = 0; which < 2; ++which) {
                    const size_t t = t0 + tp + which * 32; const int s = (int)(t & (SEQ_ - 1));
                    const u32x2 yfr = *(const u32x2*)(YF + t * 512 + c), ybr = *(const u32x2*)(YBk + t * 512 + c);
                    f32x4 y; y[0] = bf_lo(yfr.x) + bf_lo(ybr.x); y[1] = bf_hi(yfr.x) + bf_hi(ybr.x); y[2] = bf_lo(yfr.y) + bf_lo(ybr.y); y[3] = bf_hi(yfr.y) + bf_hi(ybr.y);
                    const float mean = red16d(y[0] + y[1] + y[2] + y[3]) * (1.0f / 64.0f);
                    const f32x4 d = y - mean;
                    const float var = red16d(d[0] * d[0] + d[1] * d[1] + d[2] * d[2] + d[3] * d[3]) * (1.0f / 64.0f);
                    const float rs = rsqrtf(var + 64e-5f);
                    const bf16_t* zp = ZR + t * ZRC + 1024 + c;
                    const u32x2 vc = *(const u32x2*)zp; u32x2 vp = {0u, 0u}, vn = {0u, 0u};
                    if (s > 0) vp = *(const u32x2*)(zp - ZRC);
                    if (s < SEQ_ - 1) vn = *(const u32x2*)(zp + ZRC);
                    f32x4 vcur, vprev, vnext;
                    vcur[0] = bf_lo(vc.x); vcur[1] = bf_hi(vc.x); vcur[2] = bf_lo(vc.y); vcur[3] = bf_hi(vc.y);
                    vprev[0] = bf_lo(vp.x); vprev[1] = bf_hi(vp.x); vprev[2] = bf_lo(vp.y); vprev[3] = bf_hi(vp.y);
                    vnext[0] = bf_lo(vn.x); vnext[1] = bf_hi(vn.x); vnext[2] = bf_lo(vn.y); vnext[3] = bf_hi(vn.y);
                    const f32x4 vs = vcur + m4 * ((vprev + vnext) * 0.5f - vcur);
                    const float bon = BON[t * 8 + h];
                    const f32x4 gg = which ? gB : gA;
                    const f32x4 o = (d * rs * lg + lb + vs * bon) * gg;
                    u32x2 ow; ow.x = cvt_pk_bf16(o[0], o[1]); ow.y = cvt_pk_bf16(o[2], o[3]);
                    *(u32x2*)(YF + t * 512 + c) = ow;
                }
            }
        }
    }
}

#define XB_TMO      128
#define XB_XCNT(j)  (256  + 64 * (j))
#define XB_XSUB(j)  (1280 + 64 * (j))
#define XB_XGEN(j)  (2304 + 64 * (j))
#define XB_TOP      3328
#define XB_TOPGEN   3392
#define XCD_BAR_WORDS 3456
#define XB_SPIN_CAP (1u << 22)
__device__ __forceinline__ unsigned xb_ld(unsigned* p)              { return __hip_atomic_load(p, __ATOMIC_RELAXED, __HIP_MEMORY_SCOPE_AGENT); }
__device__ __forceinline__ unsigned xb_add(unsigned* p, unsigned v) { return __hip_atomic_fetch_add(p, v, __ATOMIC_RELAXED, __HIP_MEMORY_SCOPE_AGENT); }
__device__ __forceinline__ unsigned xb_xcc_id() { return (unsigned)__builtin_amdgcn_s_getreg((3 << 11) | 20) & 0xFu; }
#define XB_SPIN(cond, bar) do { unsigned _sp = 0; while (cond) { __builtin_amdgcn_s_sleep(1); \
    if ((++_sp & 255u) == 0u) { if (xb_ld(&(bar)[XB_TMO])) break; if (_sp > XB_SPIN_CAP) { atomicAdd(&(bar)[XB_TMO], 1u); break; } } } } while (0)
struct XcdBarrier { unsigned* bar; unsigned x; volatile LAS unsigned* st; };
__device__ __forceinline__ XcdBarrier xcd_barrier_post(unsigned* bar, volatile LAS unsigned* st) {
    XcdBarrier b; b.bar = bar; b.x = xb_xcc_id(); b.st = st;
    if (threadIdx.x == 0) (void)xb_add(&bar[XB_XCNT(b.x)], 1u);
    return b;
}
__device__ __forceinline__ void xcd_barrier_complete(unsigned* bar, unsigned x, unsigned& nloc, unsigned& nx) {
    const unsigned G = gridDim.x * gridDim.y * gridDim.z;
    unsigned sum, cnt, mine, sp = 0u;
    for (;;) {
        sum = 0u; cnt = 0u; mine = 0u;
#pragma unroll
        for (unsigned j = 0; j < 16; ++j) { const unsigned c = xb_ld(&bar[XB_XCNT(j)]); sum += c; cnt += (c > 0u) ? 1u : 0u; mine = (j == x) ? c : mine; }
        if (sum == G) break;
        __builtin_amdgcn_s_sleep(1);
        if ((++sp & 255u) == 0u) { if (xb_ld(&bar[XB_TMO])) break; if (sp > XB_SPIN_CAP) { atomicAdd(&bar[XB_TMO], 1u); break; } }
    }
    nloc = mine > 0u ? mine : 1u; nx = cnt > 0u ? cnt : 1u;
}
__device__ __forceinline__ void xcd_barrier(const XcdBarrier& b) {
    asm volatile("s_waitcnt vmcnt(0)" ::: "memory");
    __syncthreads();
    if (threadIdx.x == 0) {
        unsigned* bar = b.bar;
        __builtin_amdgcn_s_waitcnt(0);
        unsigned nloc = b.st[0], nx = b.st[1];
        if (nloc == 0u) { xcd_barrier_complete(bar, b.x, nloc, nx); b.st[0] = nloc; b.st[1] = nx; }
        const unsigned old = xb_add(&bar[XB_XSUB(b.x)], 1u);
        const unsigned gen = old / nloc;
        if (old + 1u == (gen + 1u) * nloc) {
            __builtin_amdgcn_fence(__ATOMIC_RELEASE, "agent");
            asm volatile("s_waitcnt vmcnt(0)" ::: "memory");
            const unsigned og = xb_add(&bar[XB_TOP], 1u);
            const unsigned tg = og / nx;
            if (og + 1u == (tg + 1u) * nx) xb_add(&bar[XB_TOPGEN], 1u);
            else XB_SPIN(xb_ld(&bar[XB_TOPGEN]) == tg, bar);
            __builtin_amdgcn_fence(__ATOMIC_ACQUIRE, "agent");
            xb_add(&bar[XB_XGEN(b.x)], 1u);
            asm volatile("s_waitcnt vmcnt(0)" ::: "memory");
        } else {
            XB_SPIN(xb_ld(&bar[XB_XGEN(b.x)]) == gen, bar);
            __builtin_amdgcn_fence(__ATOMIC_ACQUIRE, "agent");
            asm volatile("s_waitcnt vmcnt(0)" ::: "memory");
        }
    }
    __syncthreads();
}

constexpr int PH_PER_LAYER = 14, N_PHASES = 2 * PH_PER_LAYER + 1;

__global__ void __launch_bounds__(512, 2) fwd_kernel(Params p, int ph_lo, int ph_hi) {
    extern __shared__ __attribute__((aligned(16))) unsigned char lds_raw[];
    LAS unsigned char* lds = (LAS unsigned char*)lds_raw;
    volatile LAS unsigned* bst = (volatile LAS unsigned*)(lds + 151552);
    if (threadIdx.x < 4) bst[threadIdx.x] = 0u;
    __syncthreads();
    XcdBarrier xbar; xbar.bar = (unsigned*)p.ws; xbar.x = 0; xbar.st = bst;
    if (ph_hi - ph_lo > 1) xbar = xcd_barrier_post((unsigned*)p.ws, bst);
    for (int ph = ph_lo; ph < ph_hi; ++ph) {
        const int G = NBLK(), c = BID();
        unsigned char* ws = WSP(p); float* xo = OUTP(p);
        bf16_t* W = (bf16_t*)(ws + WS_W); bf16_t* H = (bf16_t*)(ws + WS_H); bf16_t* ACT = (bf16_t*)(ws + WS_R);
        if (ph == N_PHASES - 1) { rmsnorm_phase(xo, INP(p, 35), nullptr, xo); }
        else {
            const int l = ph / PH_PER_LAYER, k = ph % PH_PER_LAYER;
            const float* xin = (l == 0) ? INP(p, 0) : xo;
            switch (k) {
            case 0: if (PHON(0)) for (int rep = 0; rep < REPS(0); ++rep) { prep_phase(p, l, lds); rmsnorm_phase(xin, INP(p, 1) + (size_t)l * D_, H, nullptr); } break;
            case 1: if (PHON(1)) for (int rep = 0; rep < REPS(1); ++rep) { pg8::Gemm g{H, W + W_GU1, T_, 5632, D_, 0, 0}; pg8::OrderPlain S; S.init(T_, 5632, G, c); pg8::EpiAct E{ACT}; pg8::gemm_phase(lds, g, S, E); } break;
            case 2: if (PHON(2)) { pg8::Gemm g{ACT, W + W_D1, T_, D_, FF_, 0, 0}; pg8::OrderPlain S; S.init(T_, D_, G, c); pg8::EpiRes E{xin, xo, 0.5f}; pg8::gemm_phase(lds, g, S, E); } break;
            case 3: if (PHON(3)) rmsnorm_phase(xo, INP(p, 5) + (size_t)l * D_, H, nullptr); break;
            case 4: if (PHON(4)) for (int rep = 0; rep < REPS(4); ++rep) { { pg8::Gemm g{H, W + W_IN, T_, ZC, D_, 0, 0}; pg8::OrderPlain S; S.init(T_, ZC, G, c); pg8::EpiZ E{(bf16_t*)(ws + WS_R + R_ZG), (bf16_t*)(ws + WS_R + R_ZR)}; pg8::gemm_phase(lds, g, S, E); }
                      { pg8::Gemm g{W + W_FOLD, H, 1024, T_, D_, 0, 0}; pg8::EpiFT E{(bf16_t*)(ws + WS_R + R_FT)};
                        if (G == 256) { pg8::OrderFill S; S.init(1024, T_, G, c, 128, 1, 3); pg8::gemm_phase(lds, g, S, E); }
                        else { pg8::OrderPlain S; S.init(1024, T_, G, c); pg8::gemm_phase(lds, g, S, E); } } } break;
            case 5: if (PHON(5)) for (int rep = 0; rep < REPS(5); ++rep) { { pg8::Gemm g{(const bf16_t*)(ws + WS_DM), (const bf16_t*)(ws + WS_R + R_FT), 1024, 512, SEQ_, (size_t)1024 * SEQ_ * 2, (size_t)512 * SEQ_ * 2, 1}; pg8::OrderBatch S; S.init(1024, 512, 2 * NB_, G, c);
                        pg8::EpiFnet E{(bf16_t*)(ws + WS_H + 32 * MiB)}; pg8::gemm_phase(lds, g, S, E); }
                      fnet_nyquist_phase(p);
                      gla_chunk_phase(p, l, lds);
                      } break;
            case 6: if (PHON(6)) { gla_post_phase(p, l); fnet_combine_phase(p); for (int rep = 0; rep < REPS(6); ++rep) {
                rwkv_chunk_phase(p, l, lds);
            } } break;
            case 7: if (PHON(7)) { rwkv_post_phase(p, l, lds); rmsnorm_phase(xo, INP(p, 5) + (size_t)l * D_, H, nullptr); } break;
            case 8: if (PHON(8)) for (int rep = 0; rep < REPS(8); ++rep) { pg8::Gemm g{H, W + W_GATE, T_, 3072, D_, 0, 0}; pg8::OrderPlain S; S.init(T_, 3072, G, c); pg8::EpiGate E{(bf16_t*)(ws + WS_R + R_G)}; pg8::gemm_phase(lds, g, S, E); } break;
            case 9: if (PHON(9)) for (int rep = 0; rep < REPS(9); ++rep) { pg8::Gemm g{(const bf16_t*)(ws + WS_Y), W + W_PROJ, T_, D_, 512, Y_STRIDE, (size_t)1024 * 512 * 2}; pg8::OrderMerge S; S.init(T_, 2 * D_, G, c);
                      pg8::EpiMerge E{(const bf16_t*)(ws + WS_R + R_G), H}; pg8::gemm_phase<pg8::EpiMerge, pg8::OrderMerge, true>(lds, g, S, E); } break;
            case 10: if (PHON(10)) { pg8::Gemm g{H, W + W_OUT, T_, D_, D_, 0, 0}; pg8::OrderPlain S; S.init(T_, D_, G, c); pg8::EpiRes E{xo, xo, 1.0f}; pg8::gemm_phase(lds, g, S, E); } break;
            case 11: if (PHON(11)) rmsnorm_phase(xo, INP(p, 31) + (size_t)l * D_, H, nullptr); break;
            case 12: if (PHON(12)) { pg8::Gemm g{H, W + W_GU2, T_, 5632, D_, 0, 0}; pg8::OrderPlain S; S.init(T_, 5632, G, c); pg8::EpiAct E{ACT}; pg8::gemm_phase(lds, g, S, E); } break;
            case 13: if (PHON(13)) { pg8::Gemm g{ACT, W + W_D2, T_, D_, FF_, 0, 0}; pg8::OrderPlain S; S.init(T_, D_, G, c); pg8::EpiRes E{xo, xo, 0.5f}; pg8::gemm_phase(lds, g, S, E); } break;
            }
        }
        if (ph + 1 < ph_hi) {
            if (ph == ph_lo) { __threadfence(); cg::this_grid().sync(); }
            else xcd_barrier(xbar);
        }
    }
}

constexpr int LDS_BYTES = 151552 + 16;

extern "C" void kernel_launch(void* const* d_in, const int* in_sizes, int n_in, void* d_out, int out_size, void* d_ws, size_t ws_size, hipStream_t stream) {
    static int grid = 0;
    if (grid == 0) {
        if (n_in != 36 || out_size != T_ * D_ || ws_size < WS_END) { fprintf(stderr, "kernel_launch: unexpected problem (n_in %d out %d ws %zu)\n", n_in, out_size, ws_size); grid = -1; return; }
        int dev = 0, cus = 0, per_cu = 0;
        hipGetDevice(&dev); hipDeviceGetAttribute(&cus, hipDeviceAttributeMultiprocessorCount, dev);
        if (hipFuncSetAttribute((const void*)fwd_kernel, hipFuncAttributeMaxDynamicSharedMemorySize, LDS_BYTES) != hipSuccess) { fprintf(stderr, "kernel_launch: hipFuncSetAttribute failed\n"); grid = -1; return; }
        hipOccupancyMaxActiveBlocksPerMultiprocessor(&per_cu, (const void*)fwd_kernel, 512, LDS_BYTES);
        (void)hipGetLastError();
        if (per_cu < 1) per_cu = 1;
        grid = cus * 1;
        fprintf(stderr, "kernel_launch: cus %d per_cu %d grid %d ws %zu\n", cus, per_cu, grid, ws_size);
    }
    if (grid < 0) return;
    Params p{};
    for (int i = 0; i < 36; ++i) p.in[i] = (const float*)d_in[i];
    p.out = (float*)d_out; p.ws = (unsigned char*)d_ws;
#if ONE_LAUNCH
    (void)hipMemsetAsync(d_ws, 0, XCD_BAR_WORDS * 4, stream);
    int lo = 0, hi = N_PHASES;
    void* args[] = {&p, &lo, &hi};
    hipError_t e = hipLaunchCooperativeKernel((const void*)fwd_kernel, dim3(grid), dim3(512), args, LDS_BYTES, stream);
    if (e != hipSuccess) fprintf(stderr, "cooperative launch failed: %s (grid %d)\n", hipGetErrorString(e), grid);
#else
    for (int ph = 0; ph < N_PHASES; ++ph) hipLaunchKernelGGL(fwd_kernel, dim3(grid), dim3(512), LDS_BYTES, stream, p, ph, ph + 1);
#endif
}
```
